# Optimizing an MI355X kernel written in HIP

```python
import math
import jax, jax.numpy as jnp
from jax import lax
import numpy as np

D_MODEL = 1024
BATCH = 16
SEQ = 2048
DEPTH = 4
DEC_BATCH = 1
DEC_SEQ = 16384
PAST_LEN = 128

EPS = 1e-6
N_EVEN = (DEPTH + 1) // 2
N_ODD = DEPTH // 2

A_HEADS = 8
A_KV_HEADS = 2
A_HEAD_DIM = 64
A_WINDOW = 128
A_BLOCK = 128
A_Q_DIM = A_HEADS * A_HEAD_DIM
A_KV_DIM = A_KV_HEADS * A_HEAD_DIM
T5_BUCKETS = 32
T5_MAX_DIST = 128

SSD_HEADS = 16
SSD_HEAD_DIM = 64
SSD_INNER = SSD_HEADS * SSD_HEAD_DIM
SSD_GROUPS = 2
SSD_STATE = 64
SSD_CONV = 5
SSD_CHUNK = 64
SSD_XBC = SSD_INNER + 2 * SSD_GROUPS * SSD_STATE

EV_SIZES = [A_Q_DIM, A_KV_DIM, A_KV_DIM, SSD_INNER, SSD_XBC, 2 * SSD_HEADS]
EV_IN = sum(EV_SIZES)
EV_SPLITS = np.cumsum(EV_SIZES)[:-1].tolist()
EV_MIX = A_Q_DIM + SSD_INNER
XBC_SPLITS = [SSD_INNER, SSD_INNER + SSD_GROUPS * SSD_STATE]

HG_HEADS = 8
HG_EXPAND = 128
HG_HEAD_V = D_MODEL // HG_HEADS
HG_FDIM = HG_HEADS * HG_EXPAND
HG_CHUNK = 32
OD_SIZES = [HG_FDIM, HG_FDIM, HG_FDIM, D_MODEL, D_MODEL]
OD_IN = sum(OD_SIZES)
OD_SPLITS = np.cumsum(OD_SIZES)[:-1].tolist()

D_FF = -(-8 * D_MODEL // (3 * 256)) * 256

kernel_name = "hybrid_bidir_swa_ssd_hgrn2_encoder"


def rmsnorm(x, w):
    xf = x.astype(jnp.float32)
    y = xf * lax.rsqrt(jnp.mean(xf * xf, axis=-1, keepdims=True) + EPS)
    return (y * w.astype(jnp.float32)).astype(x.dtype)


def _flip(t):
    return jnp.flip(t, axis=1)


def t5_bucket(rel):
    half = T5_BUCKETS // 2
    max_exact = half // 2
    n = np.abs(rel)
    large = max_exact + (np.log(np.maximum(n, 1) / max_exact)
                         / np.log(T5_MAX_DIST / max_exact) * (half - max_exact)).astype(np.int32)
    large = np.minimum(large, half - 1)
    return ((rel > 0).astype(np.int32) * half + np.where(n < max_exact, n, large)).astype(np.int32)


def windowed_gqa(q, k, v, sink, t5_bias):
    b, S = q.shape[:2]
    nb = S // A_BLOCK
    rep = A_HEADS // A_KV_HEADS
    pad = ((0, 0), (A_BLOCK, A_BLOCK), (0, 0), (0, 0))

    def bands(t):
        tb = jnp.pad(t, pad).reshape(b, nb + 2, A_BLOCK, A_KV_HEADS, A_HEAD_DIM)
        return jnp.concatenate([tb[:, :-2], tb[:, 1:-1], tb[:, 2:]], axis=2)

    kb, vb = bands(k), bands(v)
    qb = q.reshape(b, nb, A_BLOCK, A_KV_HEADS, rep, A_HEAD_DIM)
    s = jnp.einsum('bnqgrd,bnkgd->bngrqk', qb, kb,
                   preferred_element_type=jnp.float32) * (A_HEAD_DIM ** -0.5)
    qi = np.arange(A_BLOCK)[:, None]
    kj = np.arange(3 * A_BLOCK)[None, :] - A_BLOCK
    rel = kj - qi
    bias = jnp.transpose(t5_bias[t5_bucket(rel)], (2, 0, 1)).astype(jnp.float32)
    bias = bias.reshape(A_KV_HEADS, rep, A_BLOCK, 3 * A_BLOCK)
    kpos = np.arange(nb)[:, None, None] * A_BLOCK + kj[None]
    valid = (np.abs(rel)[None] <= A_WINDOW) & (kpos >= 0) & (kpos < S)
    s = jnp.where(valid[None, :, None, None], s + bias, -jnp.inf)
    sk = sink.astype(jnp.float32).reshape(1, 1, A_KV_HEADS, rep, 1, 1)
    m = jnp.maximum(jnp.max(s, axis=-1, keepdims=True), sk)
    p = jnp.exp(s - m)
    denom = jnp.sum(p, axis=-1, keepdims=True) + jnp.exp(sk - m)
    o = jnp.einsum('bngrqk,bnkgd->bnqgrd', (p / denom).astype(v.dtype), vb)
    return o.reshape(b, S, A_Q_DIM)


def dwconv_centred(x, w, bias):
    y = lax.conv_general_dilated(x, w[:, None, :].astype(x.dtype), window_strides=(1,),
                                 padding=((SSD_CONV // 2, SSD_CONV // 2),),
                                 dimension_numbers=('NWC', 'WIO', 'NWC'),
                                 feature_group_count=x.shape[-1])
    return y + bias.astype(x.dtype)


def ssd_scan(x, dt, a, bm, cm):
    b, S = x.shape[:2]
    L = SSD_CHUNK
    nc = S // L
    r = SSD_HEADS // SSD_GROUPS
    xc = (x.astype(jnp.float32) * dt[..., None]).reshape(b, nc, L, SSD_GROUPS, r, SSD_HEAD_DIM)
    cs = jnp.cumsum((dt * a).reshape(b, nc, L, SSD_GROUPS, r), axis=2)
    bc = bm.astype(jnp.float32).reshape(b, nc, L, SSD_GROUPS, SSD_STATE)
    cc = cm.astype(jnp.float32).reshape(b, nc, L, SSD_GROUPS, SSD_STATE)
    cst = jnp.moveaxis(cs, 2, -1)
    causal = np.tril(np.ones((L, L), dtype=bool))
    decay = jnp.exp(jnp.where(causal, cst[..., :, None] - cst[..., None, :], -jnp.inf))
    cb = jnp.einsum('bclgn,bcsgn->bcgls', cc, bc)
    y_diag = jnp.einsum('bcgrls,bcsgrp->bclgrp', cb[:, :, :, None] * decay, xc)
    xw = xc * jnp.exp(cs[:, :, -1:] - cs)[..., None]
    out_decay = jnp.exp(cs)
    chunk_decay = jnp.exp(cs[:, :, -1])

    def step(h, inp):
        b_c, x_c, c_c, od_c, dc = inp
        y = jnp.einsum('blgn,bgrpn->blgrp', c_c, h) * od_c[..., None]
        h = dc[..., None, None] * h + jnp.einsum('blgn,blgrp->bgrpn', b_c, x_c)
        return h, y

    h0 = jnp.zeros((b, SSD_GROUPS, r, SSD_HEAD_DIM, SSD_STATE), jnp.float32)
    seq = tuple(jnp.moveaxis(t, 1, 0) for t in (bc, xw, cc, out_decay, chunk_decay))
    _, y_off = lax.scan(step, h0, seq)
    y = y_diag + jnp.moveaxis(y_off, 0, 1)
    return y.reshape(b, S, SSD_HEADS, SSD_HEAD_DIM)


def ssd_mixer(z, xbc, dt_raw, conv_w, conv_b, a_log, dt_bias, d_skip, norm_w):
    b, S = z.shape[:2]
    xbc = jax.nn.silu(dwconv_centred(xbc, conv_w, conv_b))
    xs, bm, cm = jnp.split(xbc, XBC_SPLITS, axis=-1)
    xs = xs.reshape(b, S, SSD_HEADS, SSD_HEAD_DIM)
    bm = bm.reshape(b, S, SSD_GROUPS, SSD_STATE)
    cm = cm.reshape(b, S, SSD_GROUPS, SSD_STATE)
    dt = jax.nn.softplus(dt_raw.astype(jnp.float32).reshape(b, S, 2, SSD_HEADS)
                         + dt_bias.astype(jnp.float32))
    a = -jnp.exp(a_log.astype(jnp.float32))
    y = ssd_scan(xs, dt[:, :, 0], a[0], bm, cm)
    y = y + _flip(ssd_scan(_flip(xs), _flip(dt[:, :, 1]), a[1], _flip(bm), _flip(cm)))
    y = y + d_skip.astype(jnp.float32)[:, None] * xs.astype(jnp.float32)
    y = y.reshape(b, S, SSD_INNER) * jax.nn.silu(z.astype(jnp.float32))
    yg = y.reshape(b, S, SSD_GROUPS, SSD_INNER // SSD_GROUPS)
    yg = yg * lax.rsqrt(jnp.mean(yg * yg, axis=-1, keepdims=True) + EPS)
    return (yg.reshape(b, S, SSD_INNER) * norm_w.astype(jnp.float32)).astype(z.dtype)


def even_mixer(h, w_in, sink, t5_bias, conv_w, conv_b, a_log, dt_bias, d_skip, norm_w, w_out):
    b, S, _ = h.shape
    q, k, v, z, xbc, dt_raw = jnp.split(h @ w_in, EV_SPLITS, axis=-1)
    a_out = windowed_gqa(q.reshape(b, S, A_HEADS, A_HEAD_DIM),
                         k.reshape(b, S, A_KV_HEADS, A_HEAD_DIM),
                         v.reshape(b, S, A_KV_HEADS, A_HEAD_DIM), sink, t5_bias)
    b_out = ssd_mixer(z, xbc, dt_raw, conv_w, conv_b, a_log, dt_bias, d_skip, norm_w)
    return jnp.concatenate([a_out, b_out.astype(a_out.dtype)], axis=-1) @ w_out


def hgrn2_scan(q, k, v, logf):
    b, S = q.shape[:2]
    L = HG_CHUNK
    nc = S // L

    def chunks(t):
        return t.reshape(b, nc, L, *t.shape[2:])

    qc, kc, vc, gc = chunks(q), chunks(k), chunks(v), chunks(logf)
    G = jnp.cumsum(gc, axis=2)
    q_in = qc * jnp.exp(G)
    att = jnp.einsum('bclhk,bcshk->bchls', q_in, kc * jnp.exp(-G))
    att = jnp.where(np.tril(np.ones((L, L), dtype=bool)), att, 0.0)
    o_intra = jnp.einsum('bchls,bcshv->bclhv', att, vc)
    k_st = kc * jnp.exp(G[:, :, -1:] - G)
    chunk_decay = jnp.exp(G[:, :, -1])

    def step(st, inp):
        q_c, k_c, v_c, dc = inp
        o = jnp.einsum('blhk,bhkv->blhv', q_c, st)
        st = dc[..., None] * st + jnp.einsum('blhk,blhv->bhkv', k_c, v_c)
        return st, o

    s0 = jnp.zeros((b, HG_HEADS, HG_EXPAND, HG_HEAD_V), jnp.float32)
    seq = tuple(jnp.moveaxis(t, 1, 0) for t in (q_in, k_st, vc, chunk_decay))
    _, o_inter = lax.scan(step, s0, seq)
    return (o_intra + jnp.moveaxis(o_inter, 0, 1)).reshape(b, S, HG_HEADS, HG_HEAD_V)


def odd_mixer(h, w_in, lb, norm_w, w_out):
    b, S, _ = h.shape
    q, f_fwd, f_bwd, i, g = jnp.split(h @ w_in, OD_SPLITS, axis=-1)
    q = jax.nn.silu(q.astype(jnp.float32)).reshape(b, S, HG_HEADS, HG_EXPAND)
    i = i.astype(jnp.float32).reshape(b, S, HG_HEADS, HG_HEAD_V)
    lb = lb.reshape(HG_HEADS, HG_EXPAND)

    def gates(fraw):
        fr = fraw.astype(jnp.float32).reshape(b, S, HG_HEADS, HG_EXPAND)
        f = lb + (1.0 - lb) * jax.nn.sigmoid(fr)
        return (1.0 - lb) * jax.nn.sigmoid(-fr), jnp.log(f)

    k_f, lf_f = gates(f_fwd)
    k_b, lf_b = gates(f_bwd)
    o = hgrn2_scan(q, k_f, i, lf_f)
    o = o + _flip(hgrn2_scan(_flip(q), _flip(k_b), _flip(i), _flip(lf_b)))
    o = o * lax.rsqrt(jnp.mean(o * o, axis=-1, keepdims=True) + EPS) * norm_w.astype(jnp.float32)
    o = o.reshape(b, S, D_MODEL) * jax.nn.silu(g.astype(jnp.float32))
    return o.astype(h.dtype) @ w_out


def swiglu(h, wg, wu, wd):
    return (jax.nn.silu(h @ wg) * (h @ wu)) @ wd


def trunk(x, norm_gains, t5_bias, ev_w_in, attn_sink, ssd_conv_w, ssd_conv_b, ssd_a_log,
          ssd_dt_bias, ssd_d, ssd_norm_w, ev_w_out, od_w_in, hg_lower_bounds, hg_norm_w,
          od_w_out, ffn_w_gate, ffn_w_up, ffn_w_down):
    lb_soft = jax.nn.softmax(hg_lower_bounds.astype(jnp.float32), axis=0)
    lb_all = jnp.cumsum(lb_soft, axis=0) - lb_soft[0]
    for l in range(DEPTH):
        g = norm_gains[l]
        hn = rmsnorm(x, g[0])
        j = l // 2
        if l % 2 == 0:
            m = even_mixer(hn, ev_w_in[j], attn_sink[j], t5_bias, ssd_conv_w[j], ssd_conv_b[j],
                           ssd_a_log[j], ssd_dt_bias[j], ssd_d[j], ssd_norm_w[j], ev_w_out[j])
        else:
            m = odd_mixer(hn, od_w_in[j], lb_all[j], hg_norm_w[j], od_w_out[j])
        x = x + rmsnorm(m, g[1])
        f = swiglu(rmsnorm(x, g[2]), ffn_w_gate[l], ffn_w_up[l], ffn_w_down[l])
        x = x + rmsnorm(f, g[3])
    return x


def setup_inputs(seed: int = 0) -> dict:
    key = jax.random.key(seed)
    ks = jax.random.split(key, 20)

    def nrm(k, shape, scale):
        return scale * jax.random.normal(k, shape, jnp.float32)

    dt0 = jnp.exp(jax.random.uniform(ks[9], (N_EVEN, 2, SSD_HEADS), jnp.float32,
                                     minval=math.log(1e-3), maxval=math.log(1e-1)))
    return {
        "x_prompt": nrm(ks[0], (BATCH, SEQ, D_MODEL), 1.0),
        "x_sample": nrm(ks[1], (DEC_BATCH, DEC_SEQ, D_MODEL), 1.0),
        "norm_gains": 1.0 + nrm(ks[2], (DEPTH, 4, D_MODEL), 0.02),
        "t5_bias": nrm(ks[3], (T5_BUCKETS, A_HEADS), 0.5),
        "ev_w_in": nrm(ks[4], (N_EVEN, D_MODEL, EV_IN), D_MODEL ** -0.5),
        "attn_sink": nrm(ks[5], (N_EVEN, A_HEADS), 0.5),
        "ssd_conv_w": nrm(ks[6], (N_EVEN, SSD_CONV, SSD_XBC), SSD_CONV ** -0.5),
        "ssd_conv_b": nrm(ks[7], (N_EVEN, SSD_XBC), 0.01),
        "ssd_a_log": jnp.log(jax.random.uniform(ks[8], (N_EVEN, 2, SSD_HEADS), jnp.float32, 1.0, 16.0)),
        "ssd_dt_bias": dt0 + jnp.log(-jnp.expm1(-dt0)),
        "ssd_d": 1.0 + nrm(ks[10], (N_EVEN, SSD_HEADS), 0.1),
        "ssd_norm_w": 1.0 + nrm(ks[11], (N_EVEN, SSD_INNER), 0.02),
        "ev_w_out": nrm(ks[12], (N_EVEN, EV_MIX, D_MODEL), EV_MIX ** -0.5),
        "od_w_in": nrm(ks[13], (N_ODD, D_MODEL, OD_IN), D_MODEL ** -0.5),
        "hg_lower_bounds": nrm(ks[14], (N_ODD, HG_FDIM), 0.5),
        "hg_norm_w": 1.0 + nrm(ks[15], (N_ODD, HG_HEAD_V), 0.02),
        "od_w_out": nrm(ks[16], (N_ODD, D_MODEL, D_MODEL), D_MODEL ** -0.5),
        "ffn_w_gate": nrm(ks[17], (DEPTH, D_MODEL, D_FF), D_MODEL ** -0.5),
        "ffn_w_up": nrm(ks[18], (DEPTH, D_MODEL, D_FF), D_MODEL ** -0.5),
        "ffn_w_down": nrm(ks[19], (DEPTH, D_FF, D_MODEL), D_FF ** -0.5),
    }


def reference(x_prompt, x_sample, norm_gains, t5_bias, ev_w_in, attn_sink, ssd_conv_w, ssd_conv_b,
              ssd_a_log, ssd_dt_bias, ssd_d, ssd_norm_w, ev_w_out, od_w_in, hg_lower_bounds,
              hg_norm_w, od_w_out, ffn_w_gate, ffn_w_up, ffn_w_down):
    y_prompt = trunk(x_prompt, norm_gains, t5_bias, ev_w_in, attn_sink, ssd_conv_w, ssd_conv_b,
                     ssd_a_log, ssd_dt_bias, ssd_d, ssd_norm_w, ev_w_out, od_w_in, hg_lower_bounds,
                     hg_norm_w, od_w_out, ffn_w_gate, ffn_w_up, ffn_w_down)
    y_sample = trunk(x_sample, norm_gains, t5_bias, ev_w_in, attn_sink, ssd_conv_w, ssd_conv_b,
                     ssd_a_log, ssd_dt_bias, ssd_d, ssd_norm_w, ev_w_out, od_w_in, hg_lower_bounds,
                     hg_norm_w, od_w_out, ffn_w_gate, ffn_w_up, ffn_w_down)
    return (y_prompt, y_sample)
```

```cpp
#include <hip/hip_runtime.h>
#include <hip/hip_cooperative_groups.h>
#include <cstdio>
#include <cstdint>
namespace cg = cooperative_groups;
__device__ __forceinline__ int tid_opaque() { int t = threadIdx.x; asm volatile("" : "+v"(t)); return t; }
namespace pg8 {
#define PG8_LAS __attribute__((address_space(3)))
typedef unsigned short bf16_t;
typedef short bf16x8 __attribute__((ext_vector_type(8)));
typedef float f32x4 __attribute__((ext_vector_type(4)));
typedef unsigned u32x4 __attribute__((ext_vector_type(4)));
constexpr int BM = 256, BK = 64, HALF = 128, HTB = HALF * BK * 2  , STAGE_BYTES = 8 * HTB, NXCD = 8, WGM = 8;

__host__ __device__ __forceinline__ int lds_byte(int r, int c) { const int st = (r >> 4) * 2 + (c >> 5), rr = r & 15, cc = c & 31, ob = rr * 64 + cc * 2; return st * 1024 + (ob ^ (((ob >> 9) & 1) << 5)); }
__host__ __device__ __forceinline__ void stage_rc(int b, int& R, int& C) { const int st = b / 1024, sb = b % 1024, swz = sb ^ (((sb >> 9) & 1) << 5); R = (st >> 1) * 16 + swz / 64; C = (st & 1) * 32 + (swz % 64) / 2; }
__host__ __device__ __forceinline__ int perm32(int rho) { const int n = rho >> 4, i = rho & 15; return 8 * (i >> 2) + 4 * n + (i & 3); }

struct Unit { int pm, pn; };
struct Gemm { const bf16_t* A; const bf16_t* Bt; int M, N, K; };

struct StaticOrder {
    int nM, nN, nwg, G, c;
    __host__ __device__ void init(int M, int N, int G_, int c_) { nM = M / BM; nN = N / BM; nwg = nM * nN; G = G_; c = c_; }
    __host__ __device__ bool next(int i, Unit& u) const {
        const long L = (long)i * G + c; if (L >= nwg) return false;
        int wgid = (int)L; { const int q = nwg / NXCD, r = nwg % NXCD, xcd = wgid % NXCD, off = wgid / NXCD; wgid = (xcd < r ? xcd * (q + 1) : r * (q + 1) + (xcd - r) * q) + off; }
        const int nig = WGM * nN, gid = wgid / nig, fm = gid * WGM, gsz = (nM - fm) < WGM ? (nM - fm) : WGM;
        u.pm = fm + ((wgid % nig) % gsz); u.pn = (wgid % nig) / gsz; return true;
    }
    __device__ __forceinline__ void a_ready(const Unit&) const {}
    __device__ __forceinline__ void done(const Unit&) const {}
};

__device__ __forceinline__ unsigned cvt_pk_bf16(float lo, float hi) { unsigned r; asm volatile("v_cvt_pk_bf16_f32 %0, %1, %2" : "=v"(r) : "v"(lo), "v"(hi)); return r; }
struct EpiBf16 {
    static constexpr bool PERM = true, AFTER_DRAIN = false;
    bf16_t* O; int ldc;
    __device__ __forceinline__ void operator()(const f32x4 (&acc)[2][2][4][2], const Unit& u, int wr, int wc, int fr, int fq) const {
        const int row0 = u.pm * BM + wr * 64 + fr; const int col0 = u.pn * BM + wc * 32 + 8 * fq;
#pragma unroll
        for (int ai = 0; ai < 2; ++ai)
#pragma unroll
            for (int m = 0; m < 4; ++m) { bf16_t* rowp = O + (size_t)(row0 + ai * HALF + m * 16) * ldc + col0;
#pragma unroll
                for (int bj = 0; bj < 2; ++bj) { const f32x4 v0 = acc[ai][bj][m][0], v1 = acc[ai][bj][m][1];
                    u32x4 w; w.x = cvt_pk_bf16(v0[0], v0[1]); w.y = cvt_pk_bf16(v0[2], v0[3]); w.z = cvt_pk_bf16(v1[0], v1[1]); w.w = cvt_pk_bf16(v1[2], v1[3]);
                    *(u32x4*)(rowp + bj * HALF) = w; } }
    }
};
struct EpiF32 {
    static constexpr bool PERM = false, AFTER_DRAIN = false;
    float* O; int ldc;
    __device__ __forceinline__ void operator()(const f32x4 (&acc)[2][2][4][2], const Unit& u, int wr, int wc, int fr, int fq) const {
        const int row0 = u.pm * BM + wr * 64 + fr; const int col0 = u.pn * BM + wc * 32 + 4 * fq;
#pragma unroll
        for (int ai = 0; ai < 2; ++ai)
#pragma unroll
            for (int m = 0; m < 4; ++m) { float* rowp = O + (size_t)(row0 + ai * HALF + m * 16) * ldc + col0;
#pragma unroll
                for (int bj = 0; bj < 2; ++bj)
#pragma unroll
                    for (int n = 0; n < 2; ++n) *(f32x4*)(rowp + bj * HALF + 16 * n) = acc[ai][bj][m][n]; }
    }
};
struct EpiSwiGLU {
    static constexpr bool PERM = true, AFTER_DRAIN = false;
    bf16_t* O; int ldc;
    __device__ __forceinline__ void operator()(const f32x4 (&acc)[2][2][4][2], const Unit& u, int wr, int wc, int fr, int fq) const {
        const int row0 = u.pm * BM + wr * 64 + fr; const int col0 = u.pn * HALF + wc * 32 + 8 * fq;
#pragma unroll
        for (int ai = 0; ai < 2; ++ai)
#pragma unroll
            for (int m = 0; m < 4; ++m) { bf16_t* rowp = O + (size_t)(row0 + ai * HALF + m * 16) * ldc + col0;
                float r[8];
#pragma unroll
                for (int n = 0; n < 2; ++n)
#pragma unroll
                    for (int e = 0; e < 4; ++e) { const float g = acc[ai][0][m][n][e], up = acc[ai][1][m][n][e]; r[n * 4 + e] = g / (1.f + __expf(-g)) * up; }
                u32x4 w; w.x = cvt_pk_bf16(r[0], r[1]); w.y = cvt_pk_bf16(r[2], r[3]); w.z = cvt_pk_bf16(r[4], r[5]); w.w = cvt_pk_bf16(r[6], r[7]);
                *(u32x4*)rowp = w; }
    }
};

template <class Epi, class Sched, bool ALIGN_EPI = false, bool SP2 = false>
__device__ __forceinline__ void gemm_phase(PG8_LAS unsigned char* lds, const Gemm g, const Sched& S, const Epi& E) {
    const int tid = tid_opaque(), wid = __builtin_amdgcn_readfirstlane(tid >> 6), lane = tid & 63, wr = wid >> 2, wc = wid & 3, fr = lane & 15, fq = lane >> 4;
    const int K = g.K, nt = K / BK;
    unsigned voffA[2], voffB[2];
#pragma unroll
    for (int i = 0; i < 2; ++i) { int R, C; stage_rc(tid * 16 + i * 8192, R, C); const int Rb = Epi::PERM ? ((R & ~31) + perm32(R & 31)) : R;
        voffA[i] = (unsigned)(R * K + C) * 2u; voffB[i] = (unsigned)(Rb * K + C) * 2u; }
    const size_t kstep = (size_t)(BK * 2);
    const size_t hstep = (size_t)HALF * K * 2;
    const size_t tstep = 2 * hstep;
    const unsigned ldsw = (unsigned)wid * 1024u;
    const int aoff = lds_byte(wr * 64 + fr, fq * 8), boff = lds_byte(wc * 32 + fr, fq * 8);
#define PG8_SA(b, h) (((b) * 2 + (h)) * HTB)
#define PG8_SB(b, h) ((4 + (b) * 2 + (h)) * HTB)
#define PG8_STAGE(bufoff, gbase, voff) do { _Pragma("unroll") for (int _i = 0; _i < 2; ++_i) \
        __builtin_amdgcn_global_load_lds((const unsigned*)((const char*)(gbase) + (voff)[_i]), (PG8_LAS unsigned*)(lds + (bufoff) + ldsw + _i * 8192), 16, 0, 0); } while (0)
#define PG8_LDA(dst, b, h) do { _Pragma("unroll") for (int m = 0; m < 4; ++m) _Pragma("unroll") for (int k = 0; k < 2; ++k) dst[m][k] = *(const PG8_LAS bf16x8*)(lds + PG8_SA(b, h) + aoff + m * 2048 + k * 1024); } while (0)
#define PG8_LDB(dst, b, h) do { _Pragma("unroll") for (int n = 0; n < 2; ++n) _Pragma("unroll") for (int k = 0; k < 2; ++k) dst[n][k] = *(const PG8_LAS bf16x8*)(lds + PG8_SB(b, h) + boff + n * 2048 + k * 1024); } while (0)
#define PG8_MMA(ai, bj, At, Bt) do { __builtin_amdgcn_s_setprio(1); _Pragma("unroll") for (int m = 0; m < 4; ++m) _Pragma("unroll") for (int n = 0; n < 2; ++n) _Pragma("unroll") for (int k = 0; k < 2; ++k) \
        acc[ai][bj][m][n] = __builtin_amdgcn_mfma_f32_16x16x32_bf16(Bt[n][k], At[m][k], acc[ai][bj][m][n], 0, 0, 0); __builtin_amdgcn_s_setprio(0); } while (0)
#define PG8_WAIT_V(n) asm volatile("s_waitcnt vmcnt(" #n ")" ::: "memory")
#define PG8_WAIT_L(n) asm volatile("s_waitcnt lgkmcnt(" #n ")" ::: "memory")
#define PG8_BAR __builtin_amdgcn_s_barrier()
#define PG8_SCHED __builtin_amdgcn_sched_barrier(0)
    Unit cur, nxt; int ui = 0;
    if (!S.next(0, cur)) return;
    f32x4 acc[2][2][4][2];
#pragma unroll
    for (int a = 0; a < 2; ++a)
#pragma unroll
        for (int b = 0; b < 2; ++b)
#pragma unroll
            for (int m = 0; m < 4; ++m)
#pragma unroll
                for (int n = 0; n < 2; ++n) acc[a][b][m][n] = (f32x4){0.f, 0.f, 0.f, 0.f};
    bf16x8 At[4][2], B0[2][2], B1[2][2];
    const char* cA = (const char*)g.A + (size_t)cur.pm * tstep; const char* cB = (const char*)g.Bt + (size_t)cur.pn * tstep;
    S.a_ready(cur);
    if constexpr (SP2) {
        PG8_STAGE(PG8_SB(0, 0), cB, voffB); PG8_STAGE(PG8_SB(0, 1), cB + hstep, voffB); PG8_STAGE(PG8_SA(0, 0), cA, voffA); PG8_STAGE(PG8_SA(0, 1), cA + hstep, voffA);
        if (wr == 1) PG8_BAR;
        PG8_WAIT_V(2); PG8_BAR;
        PG8_STAGE(PG8_SB(1, 0), cB + kstep, voffB); PG8_STAGE(PG8_SA(1, 0), cA + kstep, voffA); PG8_STAGE(PG8_SB(1, 1), cB + hstep + kstep, voffB);
        PG8_WAIT_V(6); PG8_BAR;
    } else {
        PG8_STAGE(PG8_SB(0, 0), cB, voffB); PG8_STAGE(PG8_SA(0, 0), cA, voffA); PG8_STAGE(PG8_SB(0, 1), cB + hstep, voffB); PG8_STAGE(PG8_SA(0, 1), cA + hstep, voffA);
        if (wr == 1) PG8_BAR;
        PG8_WAIT_V(4); PG8_BAR;
        PG8_STAGE(PG8_SB(1, 0), cB + kstep, voffB); PG8_STAGE(PG8_SA(1, 0), cA + kstep, voffA); PG8_STAGE(PG8_SB(1, 1), cB + hstep + kstep, voffB);
        PG8_WAIT_V(6); PG8_BAR;
    }
    for (;;) {
        const bool has_next = S.next(ui + 1, nxt);
        const char* nA = has_next ? (const char*)g.A + (size_t)nxt.pm * tstep : cA; const char* nB = has_next ? (const char*)g.Bt + (size_t)nxt.pn * tstep : cB;
        for (int t = 0; t < nt; t += 2) {
            const bool last = (t == nt - 2);
            const char* a1 = cA + (size_t)(t + 1) * kstep;
            const char* a2 = last ? nA : cA + (size_t)(t + 2) * kstep; const char* b2 = last ? nB : cB + (size_t)(t + 2) * kstep;
            const char* a3 = a2 + kstep; const char* b3 = b2 + kstep;
            if (last && has_next) S.a_ready(nxt);
            if constexpr (SP2) {
            PG8_LDB(B0, 0, 0); PG8_LDB(B1, 0, 1); PG8_SCHED; PG8_LDA(At, 0, 0); PG8_STAGE(PG8_SA(1, 1), a1 + hstep, voffA);
            PG8_WAIT_V(8); PG8_WAIT_L(0); PG8_BAR; PG8_MMA(0, 0, At, B0); PG8_MMA(0, 1, At, B1); PG8_BAR; PG8_SCHED;
            PG8_LDA(At, 0, 1); PG8_STAGE(PG8_SB(0, 0), b2, voffB); PG8_STAGE(PG8_SB(0, 1), b2 + hstep, voffB); PG8_STAGE(PG8_SA(0, 0), a2, voffA);
            PG8_WAIT_V(8); PG8_WAIT_L(0); PG8_BAR; PG8_MMA(1, 0, At, B0); PG8_MMA(1, 1, At, B1); PG8_BAR; PG8_SCHED;
            PG8_LDB(B0, 1, 0); PG8_LDB(B1, 1, 1); PG8_SCHED; PG8_LDA(At, 1, 0); PG8_STAGE(PG8_SA(0, 1), a2 + hstep, voffA);
            PG8_WAIT_V(8); PG8_WAIT_L(0); PG8_BAR; PG8_MMA(0, 0, At, B0); PG8_MMA(0, 1, At, B1); PG8_BAR; PG8_SCHED;
            PG8_LDA(At, 1, 1); PG8_STAGE(PG8_SB(1, 0), b3, voffB); PG8_STAGE(PG8_SB(1, 1), b3 + hstep, voffB); PG8_STAGE(PG8_SA(1, 0), a3, voffA);
            PG8_WAIT_V(8); PG8_WAIT_L(0); PG8_BAR; PG8_MMA(1, 0, At, B0); PG8_MMA(1, 1, At, B1); PG8_BAR; PG8_SCHED;
            } else {
            PG8_LDB(B0, 0, 0); PG8_SCHED; PG8_LDA(At, 0, 0); PG8_STAGE(PG8_SA(1, 1), a1 + hstep, voffA);
            PG8_WAIT_L(8); PG8_BAR; PG8_WAIT_L(0); PG8_MMA(0, 0, At, B0); PG8_BAR; PG8_SCHED;
            PG8_LDB(B1, 0, 1); PG8_STAGE(PG8_SB(0, 0), b2, voffB);
            PG8_BAR; PG8_WAIT_L(0); PG8_MMA(0, 1, At, B1); PG8_BAR;
            PG8_LDA(At, 0, 1); PG8_STAGE(PG8_SA(0, 0), a2, voffA);
            PG8_BAR; PG8_WAIT_L(0); PG8_MMA(1, 0, At, B0); PG8_BAR; PG8_SCHED;
            PG8_STAGE(PG8_SB(0, 1), b2 + hstep, voffB);
            PG8_WAIT_V(6); PG8_BAR; PG8_MMA(1, 1, At, B1); PG8_BAR;
            PG8_LDB(B0, 1, 0); PG8_SCHED; PG8_LDA(At, 1, 0); PG8_STAGE(PG8_SA(0, 1), a2 + hstep, voffA);
            PG8_WAIT_L(8); PG8_BAR; PG8_WAIT_L(0); PG8_MMA(0, 0, At, B0); PG8_BAR; PG8_SCHED;
            PG8_LDB(B1, 1, 1); PG8_STAGE(PG8_SB(1, 0), b3, voffB);
            PG8_BAR; PG8_WAIT_L(0); PG8_MMA(0, 1, At, B1); PG8_BAR;
            PG8_LDA(At, 1, 1); PG8_STAGE(PG8_SA(1, 0), a3, voffA);
            PG8_BAR; PG8_WAIT_L(0); PG8_MMA(1, 0, At, B0); PG8_BAR; PG8_SCHED;
            PG8_STAGE(PG8_SB(1, 1), b3 + hstep, voffB);
            PG8_WAIT_V(6); PG8_BAR; PG8_MMA(1, 1, At, B1); PG8_BAR;
            }
        }
        if constexpr (ALIGN_EPI) { if (wr == 0) PG8_BAR; }
        if constexpr (!Epi::AFTER_DRAIN) { E(acc, cur, wr, wc, fr, fq); S.done(cur); }
        if (!has_next) break;
#pragma unroll
        for (int a = 0; a < 2; ++a)
#pragma unroll
            for (int b = 0; b < 2; ++b)
#pragma unroll
                for (int m = 0; m < 4; ++m)
#pragma unroll
                    for (int n = 0; n < 2; ++n) acc[a][b][m][n] = (f32x4){0.f, 0.f, 0.f, 0.f};
        cur = nxt; cA = nA; cB = nB; ++ui;
        if constexpr (ALIGN_EPI) { if (wr == 1) PG8_BAR; }
    }
    PG8_WAIT_V(0);
    if constexpr (!ALIGN_EPI) { if (wr == 0) PG8_BAR; }
    PG8_BAR;
    if constexpr (Epi::AFTER_DRAIN) { E.fused(acc, cur, wr, wc, fr, fq, lds, wid, lane); S.done(cur); }
#undef PG8_SA
#undef PG8_SB
#undef PG8_STAGE
#undef PG8_LDA
#undef PG8_LDB
#undef PG8_MMA
#undef PG8_WAIT_V
#undef PG8_WAIT_L
#undef PG8_BAR
#undef PG8_SCHED
}
}
#define LAS __attribute__((address_space(3)))
typedef unsigned short bf16;
typedef LAS unsigned char* lptr;
typedef short bf16x8 __attribute__((ext_vector_type(8)));
typedef float f32x4 __attribute__((ext_vector_type(4)));
typedef unsigned u32x4 __attribute__((ext_vector_type(4)));
typedef unsigned u32x2 __attribute__((ext_vector_type(2)));

constexpr int D = 1024, MS = 16384, NSLAB = 3, DEPTH = 4;
constexpr int EV_N = 3328, EV_NREAL = 3104, OD_N = 5120, FF = 2816, FF2 = 5632, MIXK = 1536;
constexpr float EPS = 1e-6f;
constexpr size_t MiB = 1u << 20;
constexpr size_t WS_EVIN = 1 * MiB;
constexpr size_t SZ_EVIN = (size_t)EV_N * D * 2;
constexpr size_t WS_EVOUT = WS_EVIN + 2 * SZ_EVIN;
constexpr size_t SZ_EVOUT = (size_t)D * MIXK * 2;
constexpr size_t WS_ODIN = WS_EVOUT + 2 * SZ_EVOUT;
constexpr size_t SZ_ODIN = (size_t)OD_N * D * 2;
constexpr size_t WS_ODOUT = WS_ODIN + 2 * SZ_ODIN;
constexpr size_t SZ_ODOUT = (size_t)D * D * 2;
constexpr size_t WS_FFGU = WS_ODOUT + 2 * SZ_ODOUT;
constexpr size_t SZ_FFGU = (size_t)FF2 * D * 2;
constexpr size_t WS_FFD = WS_FFGU + 4 * SZ_FFGU;
constexpr size_t SZ_FFD = (size_t)D * FF * 2;
constexpr size_t WS_WEND = WS_FFD + 4 * SZ_FFD;
static_assert(WS_WEND <= 112 * MiB, "weights region");
constexpr size_t WS_HN = 112 * MiB;
constexpr size_t WS_PROJ = 144 * MiB;
constexpr size_t WS_XACT = WS_PROJ + 104 * MiB;
constexpr size_t WS_MIX = 304 * MiB;
constexpr size_t WS_M = 352 * MiB;
constexpr size_t WS_ST = 416 * MiB;
constexpr size_t WS_DEC = 450 * MiB;
constexpr size_t WS_DT = 452 * MiB;
constexpr size_t WS_END = 456 * MiB;

constexpr int LDS_BYTES = 147456;

__device__ __forceinline__ unsigned f2bf(float f) { unsigned u = __builtin_bit_cast(unsigned, f); return (u + 0x7fffu + ((u >> 16) & 1u)) >> 16; }
__device__ __forceinline__ unsigned pk2(float lo, float hi) { return f2bf(lo) | (f2bf(hi) << 16); }
__device__ __forceinline__ float bf2f(bf16 b) { return __builtin_bit_cast(float, (unsigned)b << 16); }
__device__ __forceinline__ float bflo(unsigned u) { return __builtin_bit_cast(float, u << 16); }
__device__ __forceinline__ float bfhi(unsigned u) { return __builtin_bit_cast(float, u & 0xffff0000u); }
__device__ __forceinline__ float wave_sum(float v) {
#pragma unroll
    for (int o = 1; o < 64; o <<= 1) v += __shfl_xor(v, o);
    return v;
}
__device__ __forceinline__ float silu_f(float x) { return x / (1.f + __expf(-x)); }
__device__ __forceinline__ bf16x8 ldfrag(lptr base, int row, int strideB, int kelem) { return *(const LAS bf16x8*)(base + row * strideB + kelem * 2); }
__device__ __forceinline__ void unpack8(const u32x4 v, float (&f)[8]) {
    f[0] = bflo(v.x); f[1] = bfhi(v.x); f[2] = bflo(v.y); f[3] = bfhi(v.y); f[4] = bflo(v.z); f[5] = bfhi(v.z); f[6] = bflo(v.w); f[7] = bfhi(v.w);
}
#define MFMA16(a, b, c) __builtin_amdgcn_mfma_f32_16x16x32_bf16((a), (b), (c), 0, 0, 0)
#define LDSWAIT() asm volatile("s_waitcnt lgkmcnt(0)" ::: "memory")

struct Params {
    const float* in[20];
    float* out;
    unsigned char* ws;
    int ph_lo, ph_hi;
};

__device__ __forceinline__ void tr_matrix(const float* __restrict__ W, int K, int N, bf16* WT, int mode, int gw, int NGW, LAS float* scr, int lane) {
    const int nnb = N / 32, items = (K / 64) * nnb;
    for (int it = gw; it < items; it += NGW) {
        const int kb = it / nnb, nb = it % nnb, k0 = 64 * kb, n0 = 32 * nb;
        const int drow0 = (mode == 0) ? n0 : (256 * (n0 >> 7) + (n0 & 127) + (mode == 2 ? 128 : 0));
#pragma unroll 8
        for (int i = 0; i < 32; ++i) { const int kk = 2 * i + (lane >> 5); scr[kk * 33 + (lane & 31)] = W[(size_t)(k0 + kk) * N + n0 + (lane & 31)]; }
        LDSWAIT();
        const int c = lane & 7;
#pragma unroll
        for (int j = 0; j < 4; ++j) { const int n = (lane >> 3) + 8 * j; const LAS float* s = scr + (8 * c) * 33 + n;
            u32x4 o; o.x = pk2(s[0 * 33], s[1 * 33]); o.y = pk2(s[2 * 33], s[3 * 33]); o.z = pk2(s[4 * 33], s[5 * 33]); o.w = pk2(s[6 * 33], s[7 * 33]);
            *(u32x4*)(WT + (size_t)(drow0 + n) * K + k0 + 8 * c) = o; }
        LDSWAIT();
    }
}
__device__ __forceinline__ void p0_weights(const Params& P, lptr lds) {
    const int tid = tid_opaque(), lane = tid & 63, wave = tid >> 6;
    LAS float* scr = (LAS float*)(lds + wave * 16384);
    const int gw = blockIdx.x * 8 + wave, NGW = gridDim.x * 8;
    unsigned char* ws = P.ws;
    for (int j = 0; j < 2; ++j) {
        tr_matrix(P.in[4] + (size_t)j * D * EV_NREAL, D, EV_NREAL, (bf16*)(ws + WS_EVIN + j * SZ_EVIN), 0, gw, NGW, scr, lane);
        tr_matrix(P.in[12] + (size_t)j * MIXK * D, MIXK, D, (bf16*)(ws + WS_EVOUT + j * SZ_EVOUT), 0, gw, NGW, scr, lane);
        tr_matrix(P.in[13] + (size_t)j * D * OD_N, D, OD_N, (bf16*)(ws + WS_ODIN + j * SZ_ODIN), 0, gw, NGW, scr, lane);
        tr_matrix(P.in[16] + (size_t)j * D * D, D, D, (bf16*)(ws + WS_ODOUT + j * SZ_ODOUT), 0, gw, NGW, scr, lane);
    }
    for (int l = 0; l < 4; ++l) {
        tr_matrix(P.in[17] + (size_t)l * D * FF, D, FF, (bf16*)(ws + WS_FFGU + l * SZ_FFGU), 1, gw, NGW, scr, lane);
        tr_matrix(P.in[18] + (size_t)l * D * FF, D, FF, (bf16*)(ws + WS_FFGU + l * SZ_FFGU), 2, gw, NGW, scr, lane);
        tr_matrix(P.in[19] + (size_t)l * FF * D, FF, D, (bf16*)(ws + WS_FFD + l * SZ_FFD), 0, gw, NGW, scr, lane);
    }
    const int gt = blockIdx.x * 512 + tid, NT = gridDim.x * 512;
    for (int i = gt; i < 2 * 224 * 128; i += NT) { const int j = i / (224 * 128), r = i % (224 * 128);
        *(u32x4*)(ws + WS_EVIN + j * SZ_EVIN + (size_t)EV_NREAL * D * 2 + (size_t)r * 16) = (u32x4){0u, 0u, 0u, 0u}; }
}

__device__ __forceinline__ void p_init(const float* __restrict__ xin, float* xo, bf16* hn, const float* __restrict__ g) {
    const int tid = tid_opaque(), lane = tid & 63, wave = tid >> 6;
    const int gw = blockIdx.x * 8 + wave, NGW = gridDim.x * 8;
    for (int r = gw; r < MS; r += NGW) {
        const f32x4* xr = (const f32x4*)(xin + (size_t)r * D) + lane; f32x4 v[4]; float s = 0.f;
#pragma unroll
        for (int j = 0; j < 4; ++j) { v[j] = xr[64 * j]; s += (v[j].x * v[j].x + v[j].y * v[j].y) + (v[j].z * v[j].z + v[j].w * v[j].w); }
        const float rs = rsqrtf(wave_sum(s) * (1.f / D) + EPS);
        f32x4* xw = (f32x4*)(xo + (size_t)r * D) + lane; u32x2* ho = (u32x2*)(hn + (size_t)r * D) + lane; const f32x4* gg = (const f32x4*)g + lane;
#pragma unroll
        for (int j = 0; j < 4; ++j) { xw[64 * j] = v[j]; const f32x4 gv = gg[64 * j];
            u32x2 o; o.x = pk2(v[j].x * rs * gv.x, v[j].y * rs * gv.y); o.y = pk2(v[j].z * rs * gv.z, v[j].w * rs * gv.w); ho[64 * j] = o; }
    }
}
__device__ __forceinline__ void p_resnorm(float* x, const float* __restrict__ m, bf16* hn, const float* __restrict__ gpost, const float* __restrict__ gpre) {
    const int tid = tid_opaque(), lane = tid & 63, wave = tid >> 6;
    const int gw = blockIdx.x * 8 + wave, NGW = gridDim.x * 8;
    for (int r = gw; r < MS; r += NGW) {
        const f32x4* mr = (const f32x4*)(m + (size_t)r * D) + lane; f32x4* xr = (f32x4*)(x + (size_t)r * D) + lane;
        f32x4 mv[4], xv[4]; float s = 0.f;
#pragma unroll
        for (int j = 0; j < 4; ++j) { mv[j] = mr[64 * j]; xv[j] = xr[64 * j]; s += (mv[j].x * mv[j].x + mv[j].y * mv[j].y) + (mv[j].z * mv[j].z + mv[j].w * mv[j].w); }
        const float rs = rsqrtf(wave_sum(s) * (1.f / D) + EPS); float s2 = 0.f;
        const f32x4* gp = (const f32x4*)gpost + lane;
#pragma unroll
        for (int j = 0; j < 4; ++j) { const f32x4 gv = gp[64 * j]; xv[j] = xv[j] + mv[j] * rs * gv; xr[64 * j] = xv[j];
            s2 += (xv[j].x * xv[j].x + xv[j].y * xv[j].y) + (xv[j].z * xv[j].z + xv[j].w * xv[j].w); }
        if (gpre) {
            const float rs2 = rsqrtf(wave_sum(s2) * (1.f / D) + EPS);
            u32x2* ho = (u32x2*)(hn + (size_t)r * D) + lane; const f32x4* gg = (const f32x4*)gpre + lane;
#pragma unroll
            for (int j = 0; j < 4; ++j) { const f32x4 gv = gg[64 * j];
                u32x2 o; o.x = pk2(xv[j].x * rs2 * gv.x, xv[j].y * rs2 * gv.y); o.y = pk2(xv[j].z * rs2 * gv.z, xv[j].w * rs2 * gv.w); ho[64 * j] = o; }
        }
    }
}

__device__ __forceinline__ int t5_bucket(int rel) {
    const int n = rel < 0 ? -rel : rel;
    const int mag = n < 8 ? n : 8 + (n >= 12) + (n >= 16) + (n >= 23) + (n >= 32) + (n >= 46) + (n >= 64) + (n >= 91);
    return (rel > 0 ? 16 : 0) + mag;
}
__device__ __forceinline__ void p_attn(lptr lds, const bf16* __restrict__ proj, bf16* mix, const float* __restrict__ t5, const float* __restrict__ sink, int S) {
    const int tid = tid_opaque(), lane = tid & 63, w = tid >> 6, r16 = lane & 15, q4 = lane >> 4;
    constexpr int KSB = 144, VSB = 784;
    lptr sK = lds, sVT = lds + 55296; LAS float* sBias = (LAS float*)(lds + 105472);
    const int bps = S / 128;
    for (int u = blockIdx.x; u < 256; u += gridDim.x) {
        const int g = u & 1, qb = u >> 1, n = qb % bps, row_q0 = qb * 128;
        __syncthreads();
        for (int i = tid; i < 4 * 257; i += 512) { const int r = i / 257, d = i % 257; sBias[r * 260 + d] = t5[t5_bucket(d - 128) * 8 + 4 * g + r]; }
        for (int c = tid; c < 3072; c += 512) {
            const int key = c >> 3, part = c & 7; const int kpos = n * 128 - 128 + key;
            u32x4 kv = (u32x4){0u, 0u, 0u, 0u}, vv = kv;
            if (kpos >= 0 && kpos < S) { const bf16* pr = proj + (size_t)(row_q0 - 128 + key) * EV_N + g * 64 + 8 * part;
                kv = *(const u32x4*)(pr + 512); vv = *(const u32x4*)(pr + 640); }
            *(LAS u32x4*)(sK + key * KSB + part * 16) = kv;
            LAS bf16* vt = (LAS bf16*)(sVT + (8 * part) * VSB) + key;
            vt[0 * (VSB / 2)] = (bf16)(vv.x & 0xffffu); vt[1 * (VSB / 2)] = (bf16)(vv.x >> 16); vt[2 * (VSB / 2)] = (bf16)(vv.y & 0xffffu); vt[3 * (VSB / 2)] = (bf16)(vv.y >> 16);
            vt[4 * (VSB / 2)] = (bf16)(vv.z & 0xffffu); vt[5 * (VSB / 2)] = (bf16)(vv.z >> 16); vt[6 * (VSB / 2)] = (bf16)(vv.w & 0xffffu); vt[7 * (VSB / 2)] = (bf16)(vv.w >> 16);
        }
        __syncthreads();
        const int r = w >> 1, h = 4 * g + r, qh = w & 1;
        const float snk = sink[h];
        for (int qg = 0; qg < 4; ++qg) {
            const int qi = 64 * qh + 16 * qg + r16;
            const bf16* qp = proj + (size_t)(row_q0 + qi) * EV_N + h * 64 + 8 * q4;
            const bf16x8 bq0 = *(const bf16x8*)qp, bq1 = *(const bf16x8*)(qp + 32);
            f32x4 sc[24];
#pragma unroll
            for (int kt = 0; kt < 24; ++kt) { f32x4 a = (f32x4){0.f, 0.f, 0.f, 0.f};
                a = MFMA16(ldfrag(sK, kt * 16 + r16, KSB, 8 * q4), bq0, a); a = MFMA16(ldfrag(sK, kt * 16 + r16, KSB, 32 + 8 * q4), bq1, a); sc[kt] = a; if ((kt & 3) == 3) __builtin_amdgcn_sched_barrier(0); }
            float mx = -INFINITY;
            const int relb = 4 * q4 - 128 - qi, kposb = n * 128 - 128 + 4 * q4;
            const LAS float* bl = sBias + r * 260 + relb + 128;
#pragma unroll
            for (int kt = 0; kt < 24; ++kt)
#pragma unroll
                for (int e = 0; e < 4; ++e) { const int rel = relb + kt * 16 + e, kpos = kposb + kt * 16 + e;
                    const bool valid = ((unsigned)(rel + 128) <= 256u) && ((unsigned)kpos < (unsigned)S);
                    const float s = valid ? sc[kt][e] * 0.125f + bl[kt * 16 + e] : -INFINITY;
                    sc[kt][e] = s; mx = fmaxf(mx, s); }
            mx = fmaxf(mx, __shfl_xor(mx, 16)); mx = fmaxf(mx, __shfl_xor(mx, 32)); mx = fmaxf(mx, snk);
            float sum = 0.f;
#pragma unroll
            for (int kt = 0; kt < 24; ++kt)
#pragma unroll
                for (int e = 0; e < 4; ++e) { const float p = __expf(sc[kt][e] - mx); sc[kt][e] = p; sum += p; }
            sum += __shfl_xor(sum, 16); sum += __shfl_xor(sum, 32);
            const float inv = 1.f / (sum + __expf(snk - mx));
            f32x4 o[4];
#pragma unroll
            for (int dt = 0; dt < 4; ++dt) o[dt] = (f32x4){0.f, 0.f, 0.f, 0.f};
#pragma unroll
            for (int kk = 0; kk < 12; ++kk) {
                u32x4 pb; pb.x = pk2(sc[2 * kk][0], sc[2 * kk][1]); pb.y = pk2(sc[2 * kk][2], sc[2 * kk][3]); pb.z = pk2(sc[2 * kk + 1][0], sc[2 * kk + 1][1]); pb.w = pk2(sc[2 * kk + 1][2], sc[2 * kk + 1][3]);
                const bf16x8 bp = __builtin_bit_cast(bf16x8, pb);
#pragma unroll
                for (int dt = 0; dt < 4; ++dt) {
                    lptr vp = sVT + (16 * dt + r16) * VSB + (32 * kk + 4 * q4) * 2;
                    const u32x2 lo = *(const LAS u32x2*)vp, hi = *(const LAS u32x2*)(vp + 32);
                    const u32x4 av = (u32x4){lo.x, lo.y, hi.x, hi.y};
                    o[dt] = MFMA16(__builtin_bit_cast(bf16x8, av), bp, o[dt]);
                }
                __builtin_amdgcn_sched_barrier(0);
            }
            bf16* op = mix + (size_t)(row_q0 + qi) * MIXK + h * 64 + 4 * q4;
#pragma unroll
            for (int dt = 0; dt < 4; ++dt) { u32x2 ov; ov.x = pk2(o[dt][0] * inv, o[dt][1] * inv); ov.y = pk2(o[dt][2] * inv, o[dt][3] * inv); *(u32x2*)(op + 16 * dt) = ov; }
        }
    }
}

__device__ __forceinline__ void p_conv(const bf16* __restrict__ proj, bf16* xact, float* dtv, const float* __restrict__ cw, const float* __restrict__ cb, const float* __restrict__ dtb, int S) {
    const int gt = blockIdx.x * 512 + tid_opaque(), NT = gridDim.x * 512;
    for (int i = gt; i < MS * 160; i += NT) {
        const int row = i / 160, c8 = (i % 160) * 8, t = row % S;
        float acc[8];
#pragma unroll
        for (int e = 0; e < 8; ++e) acc[e] = cb[c8 + e];
#pragma unroll
        for (int k = 0; k < 5; ++k) { const int tt = t + k - 2;
            if (tt >= 0 && tt < S) { float xv[8]; unpack8(*(const u32x4*)(proj + (size_t)(row + k - 2) * EV_N + 1792 + c8), xv);
#pragma unroll
                for (int e = 0; e < 8; ++e) acc[e] += xv[e] * cw[k * 1280 + c8 + e]; } }
        u32x4 o; o.x = pk2(silu_f(acc[0]), silu_f(acc[1])); o.y = pk2(silu_f(acc[2]), silu_f(acc[3])); o.z = pk2(silu_f(acc[4]), silu_f(acc[5])); o.w = pk2(silu_f(acc[6]), silu_f(acc[7]));
        *(u32x4*)(xact + (size_t)row * 1280 + c8) = o;
    }
    for (int i = gt; i < MS * 32; i += NT) { const int row = i >> 5, c = i & 31;
        const float x = bf2f(proj[(size_t)row * EV_N + 3072 + c]) + dtb[c];
        dtv[i] = x > 20.f ? x : log1pf(__expf(x)); }
}

template <bool FINAL>
__device__ __forceinline__ void ssd_scan(lptr lds, const bf16* __restrict__ xact, const float* __restrict__ dtv, const float* __restrict__ a_log, float* ST, float* DEC, bf16* yF, bf16* yB) {
    const int tid = tid_opaque(), lane = tid & 63, w = tid >> 6, r16 = lane & 15, q4 = lane >> 4;
    constexpr int SB = 144;
    lptr sC = lds, sB = lds + 9216, sBT = lds + 18432, sXT = lds + 27648, sXwT = lds + 36864, sW = lds + 46080, sH = lds + 55296;
    LAS float* sdt = (LAS float*)(lds + 64512); LAS float* scs = sdt + 64;
    const int ti = w >> 1, tj0 = 2 * (w & 1);
    const int l_ld = tid >> 3, part = tid & 7;
    for (int u = blockIdx.x; u < 1024; u += gridDim.x) {
        const int dir = u & 1, h = (u >> 1) & 15, seg = u >> 5, g = h >> 3;
        const float a = -__expf(a_log[dir * 16 + h]);
        const int row_seg0 = seg * 512;
        bf16* ydir = dir ? yB : yF;
        f32x4 hacc[2];
#pragma unroll
        for (int jj = 0; jj < 2; ++jj) {
            if (FINAL) { const int p = 16 * (tj0 + jj) + r16, n0 = 16 * ti + 4 * q4; const float* sp = ST + (size_t)u * 4096 + n0 * 64 + p;
                hacc[jj] = (f32x4){sp[0], sp[64], sp[128], sp[192]};
                u32x2 hv; hv.x = pk2(hacc[jj][0], hacc[jj][1]); hv.y = pk2(hacc[jj][2], hacc[jj][3]); *(LAS u32x2*)(sH + p * SB + n0 * 2) = hv;
            } else hacc[jj] = (f32x4){0.f, 0.f, 0.f, 0.f};
        }
        float cs_tot = 0.f;
        for (int ci = 0; ci < 8; ++ci) {
            const int c = dir ? 7 - ci : ci, row_c0 = row_seg0 + c * 64;
            if (w == 0) { const int row = dir ? row_c0 + 63 - lane : row_c0 + lane; const float dt = dtv[row * 32 + dir * 16 + h]; float x = dt * a;
#pragma unroll
                for (int o = 1; o < 64; o <<= 1) { const float y = __shfl_up(x, o); if (lane >= o) x += y; }
                sdt[lane] = dt; scs[lane] = x; }
            const int row_l = dir ? row_c0 + 63 - l_ld : row_c0 + l_ld;
            const bf16* xr = xact + (size_t)row_l * 1280;
            const u32x4 xv = *(const u32x4*)(xr + h * 64 + 8 * part), bv = *(const u32x4*)(xr + 1024 + g * 64 + 8 * part);
            *(LAS u32x4*)(sB + l_ld * SB + part * 16) = bv;
            if (FINAL) { const u32x4 cv = *(const u32x4*)(xr + 1152 + g * 64 + 8 * part); *(LAS u32x4*)(sC + l_ld * SB + part * 16) = cv; }
            { LAS bf16* bt = (LAS bf16*)(sBT + (8 * part) * SB) + l_ld; constexpr int RS = SB / 2;
              bt[0] = (bf16)(bv.x & 0xffffu); bt[RS] = (bf16)(bv.x >> 16); bt[2 * RS] = (bf16)(bv.y & 0xffffu); bt[3 * RS] = (bf16)(bv.y >> 16);
              bt[4 * RS] = (bf16)(bv.z & 0xffffu); bt[5 * RS] = (bf16)(bv.z >> 16); bt[6 * RS] = (bf16)(bv.w & 0xffffu); bt[7 * RS] = (bf16)(bv.w >> 16); }
            if (FINAL) { LAS bf16* xt = (LAS bf16*)(sXT + (8 * part) * SB) + l_ld; constexpr int RS = SB / 2;
              xt[0] = (bf16)(xv.x & 0xffffu); xt[RS] = (bf16)(xv.x >> 16); xt[2 * RS] = (bf16)(xv.y & 0xffffu); xt[3 * RS] = (bf16)(xv.y >> 16);
              xt[4 * RS] = (bf16)(xv.z & 0xffffu); xt[5 * RS] = (bf16)(xv.z >> 16); xt[6 * RS] = (bf16)(xv.w & 0xffffu); xt[7 * RS] = (bf16)(xv.w >> 16); }
            __syncthreads();
            const float cs_last = scs[63];
            { const float wl = __expf(cs_last - scs[l_ld]) * sdt[l_ld]; float xf[8]; unpack8(xv, xf);
              LAS bf16* xt = (LAS bf16*)(sXwT + (8 * part) * SB) + l_ld; constexpr int RS = SB / 2;
#pragma unroll
              for (int e = 0; e < 8; ++e) xt[e * RS] = (bf16)f2bf(xf[e] * wl); }
            __syncthreads();
            if (FINAL) {
                f32x4 yo[2];
#pragma unroll
                for (int jj = 0; jj < 2; ++jj) { const int j = tj0 + jj;
                    f32x4 acc = (f32x4){0.f, 0.f, 0.f, 0.f};
                    if (j <= ti) {
#pragma unroll
                        for (int ks = 0; ks < 2; ++ks) acc = MFMA16(ldfrag(sC, 16 * ti + r16, SB, 32 * ks + 8 * q4), ldfrag(sB, 16 * j + r16, SB, 32 * ks + 8 * q4), acc);
                    }
                    const int s = 16 * j + r16; const float css = scs[s], dts = sdt[s];
#pragma unroll
                    for (int e = 0; e < 4; ++e) { const int l = 16 * ti + 4 * q4 + e; const float v = (s <= l) ? acc[e] * __expf(scs[l] - css) * dts : 0.f;
                        *((LAS bf16*)(sW + l * SB) + s) = (bf16)f2bf(v); }
                    f32x4 y2 = (f32x4){0.f, 0.f, 0.f, 0.f};
#pragma unroll
                    for (int ks = 0; ks < 2; ++ks) y2 = MFMA16(ldfrag(sC, 16 * ti + r16, SB, 32 * ks + 8 * q4), ldfrag(sH, 16 * j + r16, SB, 32 * ks + 8 * q4), y2);
                    yo[jj] = y2;
                }
                __syncthreads();
#pragma unroll
                for (int jj = 0; jj < 2; ++jj) { const int j = tj0 + jj;
                    f32x4 acc = (f32x4){0.f, 0.f, 0.f, 0.f};
#pragma unroll
                    for (int ks = 0; ks < 2; ++ks) acc = MFMA16(ldfrag(sW, 16 * ti + r16, SB, 32 * ks + 8 * q4), ldfrag(sXT, 16 * j + r16, SB, 32 * ks + 8 * q4), acc);
#pragma unroll
                    for (int e = 0; e < 4; ++e) { const int l = 16 * ti + 4 * q4 + e; const float y = acc[e] + __expf(scs[l]) * yo[jj][e];
                        const int row = dir ? row_c0 + 63 - l : row_c0 + l; ydir[(size_t)row * D + h * 64 + 16 * j + r16] = (bf16)f2bf(y); }
                }
            }
            const float dcay = __expf(cs_last);
#pragma unroll
            for (int jj = 0; jj < 2; ++jj) { hacc[jj] = hacc[jj] * dcay;
#pragma unroll
                for (int ks = 0; ks < 2; ++ks) hacc[jj] = MFMA16(ldfrag(sBT, 16 * ti + r16, SB, 32 * ks + 8 * q4), ldfrag(sXwT, 16 * (tj0 + jj) + r16, SB, 32 * ks + 8 * q4), hacc[jj]);
                if (FINAL) { const int p = 16 * (tj0 + jj) + r16, n0 = 16 * ti + 4 * q4;
                    u32x2 hv; hv.x = pk2(hacc[jj][0], hacc[jj][1]); hv.y = pk2(hacc[jj][2], hacc[jj][3]); *(LAS u32x2*)(sH + p * SB + n0 * 2) = hv; }
            }
            cs_tot += cs_last;
            __syncthreads();
        }
        if (!FINAL) {
#pragma unroll
            for (int jj = 0; jj < 2; ++jj) { const int p = 16 * (tj0 + jj) + r16, n0 = 16 * ti + 4 * q4; float* sp = ST + (size_t)u * 4096 + n0 * 64 + p;
                sp[0] = hacc[jj][0]; sp[64] = hacc[jj][1]; sp[128] = hacc[jj][2]; sp[192] = hacc[jj][3]; }
            if (tid == 0) DEC[u] = __expf(cs_tot);
        }
    }
}
__device__ __forceinline__ void ssd_passB(float* ST, const float* __restrict__ DEC, int nseq, int nseg) {
    const int gt = blockIdx.x * 512 + tid_opaque(), NT = gridDim.x * 512;
    const int total = nseq * 32 * 4096;
    for (int e = gt; e < total; e += NT) {
        const int el = e & 4095, chain = e >> 12, hd = chain & 31, seq = chain >> 5, h = hd >> 1, dir = hd & 1;
        float run = 0.f;
        for (int i = 0; i < nseg; ++i) { const int sl = dir ? nseg - 1 - i : i, u = ((seq * nseg + sl) * 16 + h) * 2 + dir;
            float* sp = ST + (size_t)u * 4096 + el; const float t = *sp; *sp = run; run = DEC[u] * run + t; }
    }
}
__device__ __forceinline__ void ssd_post(const bf16* __restrict__ proj, const bf16* __restrict__ xact, const bf16* __restrict__ yF, const bf16* __restrict__ yB, bf16* mix, const float* __restrict__ dsk, const float* __restrict__ nw) {
    const int tid = tid_opaque(), lane = tid & 63, wave = tid >> 6;
    const int gw = blockIdx.x * 8 + wave, NGW = gridDim.x * 8;
    for (int it = gw; it < MS * 2; it += NGW) {
        const int row = it >> 1, grp = it & 1, c = grp * 512 + lane * 8;
        float a[8], b[8], x[8], z[8], y[8];
        unpack8(*(const u32x4*)(yF + (size_t)row * D + c), a); unpack8(*(const u32x4*)(yB + (size_t)row * D + c), b);
        unpack8(*(const u32x4*)(xact + (size_t)row * 1280 + c), x); unpack8(*(const u32x4*)(proj + (size_t)row * EV_N + 768 + c), z);
        const float dd = dsk[c >> 6]; float ss = 0.f;
#pragma unroll
        for (int e = 0; e < 8; ++e) { y[e] = (a[e] + b[e] + dd * x[e]) * silu_f(z[e]); ss += y[e] * y[e]; }
        const float rs = rsqrtf(wave_sum(ss) * (1.f / 512.f) + EPS);
        const f32x4 w0 = *(const f32x4*)(nw + c), w1 = *(const f32x4*)(nw + c + 4);
        u32x4 o; o.x = pk2(y[0] * rs * w0.x, y[1] * rs * w0.y); o.y = pk2(y[2] * rs * w0.z, y[3] * rs * w0.w); o.z = pk2(y[4] * rs * w1.x, y[5] * rs * w1.y); o.w = pk2(y[6] * rs * w1.z, y[7] * rs * w1.w);
        *(u32x4*)(mix + (size_t)row * MIXK + 512 + c) = o;
    }
}

template <bool FINAL>
__device__ __forceinline__ void hg_scan(lptr lds, const bf16* __restrict__ proj, const float* __restrict__ lbraw, int j, float* ST, float* DEC, bf16* oF, bf16* oB) {
    const int tid = tid_opaque(), lane = tid & 63, w = tid >> 6, r16 = lane & 15, q4 = lane >> 4;
    constexpr int SQB = 272, STB = 80;
    lptr sQ = lds, sKn = lds + 8704, sKsT = lds + 17408, sVT = lds + 27648, sAtt = lds + 37888, sSt = lds + 40448;
    LAS float* sdc = (LAS float*)(lds + 75264); LAS float* spart = (LAS float*)(lds + 75776);
    const int k = tid & 127, part = tid >> 7;
    for (int u = blockIdx.x; u < 512; u += gridDim.x) {
        const int dir = u & 1, h = (u >> 1) & 7, seg = u >> 4;
        const float lb = (j == 0) ? 0.f : 1.f / (1.f + __expf(lbraw[h * 128 + k] - lbraw[1024 + h * 128 + k]));
        const int row_seg0 = seg * 512;
        bf16* odir = dir ? oB : oF;
        f32x4 sacc[8];
#pragma unroll
        for (int vt = 0; vt < 8; ++vt) {
            if (FINAL) { const int v = 16 * vt + r16, k0 = 16 * w + 4 * q4; const float* sp = ST + (size_t)u * 16384 + k0 * 128 + v;
                sacc[vt] = (f32x4){sp[0], sp[128], sp[256], sp[384]};
                u32x2 hv; hv.x = pk2(sacc[vt][0], sacc[vt][1]); hv.y = pk2(sacc[vt][2], sacc[vt][3]); *(LAS u32x2*)(sSt + v * SQB + k0 * 2) = hv;
            } else sacc[vt] = (f32x4){0.f, 0.f, 0.f, 0.f};
        }
        float gtot = 0.f;
        for (int ci = 0; ci < 16; ++ci) {
            const int c = dir ? 15 - ci : ci, row_c0 = row_seg0 + c * 32;
            float qv[8], kk[8], G[8]; float run = 0.f; unsigned vp[4];
#pragma unroll
            for (int i = 0; i < 8; ++i) { const int l = 8 * part + i, row = dir ? row_c0 + 31 - l : row_c0 + l;
                const bf16* pr = proj + (size_t)row * OD_N + h * 128 + k;
                const float fr = bf2f(pr[1024 + dir * 1024]);
                if (FINAL) qv[i] = silu_f(bf2f(pr[0]));
                const unsigned vb = pr[3072];
                if (i & 1) vp[i >> 1] |= vb << 16; else vp[i >> 1] = vb;
                const float sig = 1.f / (1.f + __expf(-fr)); const float f = lb + (1.f - lb) * sig;
                kk[i] = (1.f - lb) * (1.f - sig); run += __logf(fmaxf(f, 1e-30f)); G[i] = run; }
            spart[part * 128 + k] = run;
            *(LAS u32x4*)(sVT + k * STB + part * 16) = (u32x4){vp[0], vp[1], vp[2], vp[3]};
            __syncthreads();
            float prefix = 0.f, total = 0.f;
#pragma unroll
            for (int pp = 0; pp < 4; ++pp) { const float t = spart[pp * 128 + k]; total += t; if (pp < part) prefix += t; }
            float ks8[8];
#pragma unroll
            for (int i = 0; i < 8; ++i) { const float Gi = prefix + G[i]; const int l = 8 * part + i;
                if (FINAL) { *((LAS bf16*)(sQ + l * SQB) + k) = (bf16)f2bf(qv[i] * __expf(Gi)); *((LAS bf16*)(sKn + l * SQB) + k) = (bf16)f2bf(kk[i] * __expf(fminf(-Gi, 80.f))); }
                ks8[i] = kk[i] * __expf(total - Gi); }
            *(LAS u32x4*)(sKsT + k * STB + part * 16) = (u32x4){pk2(ks8[0], ks8[1]), pk2(ks8[2], ks8[3]), pk2(ks8[4], ks8[5]), pk2(ks8[6], ks8[7])};
            if (part == 0) { sdc[k] = __expf(total); gtot += total; }
            __syncthreads();
            f32x4 oacc[2];
            if (FINAL) {
                if (w < 4) { const int i = w >> 1, jt = w & 1; f32x4 acc = (f32x4){0.f, 0.f, 0.f, 0.f};
                    if (jt <= i) {
#pragma unroll
                        for (int ks = 0; ks < 4; ++ks) acc = MFMA16(ldfrag(sQ, 16 * i + r16, SQB, 32 * ks + 8 * q4), ldfrag(sKn, 16 * jt + r16, SQB, 32 * ks + 8 * q4), acc);
                    }
                    const int s = 16 * jt + r16;
#pragma unroll
                    for (int e = 0; e < 4; ++e) { const int l = 16 * i + 4 * q4 + e; *((LAS bf16*)(sAtt + l * STB) + s) = (bf16)f2bf((s <= l) ? acc[e] : 0.f); }
                }
#pragma unroll
                for (int lt = 0; lt < 2; ++lt) { f32x4 acc = (f32x4){0.f, 0.f, 0.f, 0.f};
#pragma unroll
                    for (int ks = 0; ks < 4; ++ks) acc = MFMA16(ldfrag(sQ, 16 * lt + r16, SQB, 32 * ks + 8 * q4), ldfrag(sSt, 16 * w + r16, SQB, 32 * ks + 8 * q4), acc);
                    oacc[lt] = acc; }
                __syncthreads();
#pragma unroll
                for (int lt = 0; lt < 2; ++lt) { oacc[lt] = MFMA16(ldfrag(sAtt, 16 * lt + r16, STB, 8 * q4), ldfrag(sVT, 16 * w + r16, STB, 8 * q4), oacc[lt]);
#pragma unroll
                    for (int e = 0; e < 4; ++e) { const int l = 16 * lt + 4 * q4 + e, row = dir ? row_c0 + 31 - l : row_c0 + l;
                        odir[(size_t)row * D + h * 128 + 16 * w + r16] = (bf16)f2bf(oacc[lt][e]); } }
            }
            { const bf16x8 af = ldfrag(sKsT, 16 * w + r16, STB, 8 * q4);
              const f32x4 dcv = *(const LAS f32x4*)(sdc + 16 * w + 4 * q4);
#pragma unroll
              for (int vt = 0; vt < 8; ++vt) { sacc[vt] = sacc[vt] * dcv; sacc[vt] = MFMA16(af, ldfrag(sVT, 16 * vt + r16, STB, 8 * q4), sacc[vt]);
                  if (FINAL) { const int v = 16 * vt + r16, k0 = 16 * w + 4 * q4;
                      u32x2 hv; hv.x = pk2(sacc[vt][0], sacc[vt][1]); hv.y = pk2(sacc[vt][2], sacc[vt][3]); *(LAS u32x2*)(sSt + v * SQB + k0 * 2) = hv; } } }
            __syncthreads();
        }
        if (!FINAL) {
#pragma unroll
            for (int vt = 0; vt < 8; ++vt) { const int v = 16 * vt + r16, k0 = 16 * w + 4 * q4; float* sp = ST + (size_t)u * 16384 + k0 * 128 + v;
                sp[0] = sacc[vt][0]; sp[128] = sacc[vt][1]; sp[256] = sacc[vt][2]; sp[384] = sacc[vt][3]; }
            if (part == 0) DEC[u * 128 + k] = __expf(gtot);
        }
    }
}
__device__ __forceinline__ void hg_passB(float* ST, const float* __restrict__ DEC, int nseq, int nseg) {
    const int gt = blockIdx.x * 512 + tid_opaque(), NT = gridDim.x * 512;
    const int total = nseq * 16 * 16384;
    for (int e = gt; e < total; e += NT) {
        const int el = e & 16383, chain = e >> 14, hd = chain & 15, seq = chain >> 4, h = hd >> 1, dir = hd & 1;
        float run = 0.f;
        for (int i = 0; i < nseg; ++i) { const int sl = dir ? nseg - 1 - i : i, u = ((seq * nseg + sl) * 8 + h) * 2 + dir;
            float* sp = ST + (size_t)u * 16384 + el; const float t = *sp; *sp = run; run = DEC[u * 128 + (el >> 7)] * run + t; }
    }
}
__device__ __forceinline__ void hg_post(const bf16* __restrict__ proj, const bf16* __restrict__ oF, const bf16* __restrict__ oB, bf16* mix, const float* __restrict__ nw) {
    const int tid = tid_opaque(), lane = tid & 63, wave = tid >> 6;
    const int gw = blockIdx.x * 8 + wave, NGW = gridDim.x * 8;
    for (int row = gw; row < MS; row += NGW) {
        const int c = lane * 16;
        float a[16], b[8], gg[16];
        unpack8(*(const u32x4*)(oF + (size_t)row * D + c), b);
#pragma unroll
        for (int e = 0; e < 8; ++e) a[e] = b[e];
        unpack8(*(const u32x4*)(oF + (size_t)row * D + c + 8), b);
#pragma unroll
        for (int e = 0; e < 8; ++e) a[8 + e] = b[e];
        unpack8(*(const u32x4*)(oB + (size_t)row * D + c), b);
#pragma unroll
        for (int e = 0; e < 8; ++e) a[e] += b[e];
        unpack8(*(const u32x4*)(oB + (size_t)row * D + c + 8), b);
#pragma unroll
        for (int e = 0; e < 8; ++e) a[8 + e] += b[e];
        unpack8(*(const u32x4*)(proj + (size_t)row * OD_N + 4096 + c), b);
#pragma unroll
        for (int e = 0; e < 8; ++e) gg[e] = b[e];
        unpack8(*(const u32x4*)(proj + (size_t)row * OD_N + 4096 + c + 8), b);
#pragma unroll
        for (int e = 0; e < 8; ++e) gg[8 + e] = b[e];
        float ss = 0.f;
#pragma unroll
        for (int e = 0; e < 16; ++e) ss += a[e] * a[e];
        ss += __shfl_xor(ss, 1); ss += __shfl_xor(ss, 2); ss += __shfl_xor(ss, 4);
        const float rs = rsqrtf(ss * (1.f / 128.f) + EPS);
        float o[16];
#pragma unroll
        for (int e = 0; e < 16; ++e) o[e] = a[e] * rs * nw[(c & 127) + e] * silu_f(gg[e]);
        u32x4 o0, o1; o0.x = pk2(o[0], o[1]); o0.y = pk2(o[2], o[3]); o0.z = pk2(o[4], o[5]); o0.w = pk2(o[6], o[7]);
        o1.x = pk2(o[8], o[9]); o1.y = pk2(o[10], o[11]); o1.z = pk2(o[12], o[13]); o1.w = pk2(o[14], o[15]);
        *(u32x4*)(mix + (size_t)row * D + c) = o0; *(u32x4*)(mix + (size_t)row * D + c + 8) = o1;
    }
}

constexpr int PH_PER_SLAB = 1 + 2 * (11 + 10);
constexpr int N_PHASES = 1 + NSLAB * PH_PER_SLAB;

__global__ void __launch_bounds__(512, 2) mega(Params P) {
    extern __shared__ __attribute__((aligned(16))) unsigned char lds_raw[];
    lptr lds = (lptr)lds_raw;
    cg::grid_group grid = cg::this_grid();
    const int lo = P.ph_lo, hi = P.ph_hi; int pc = 0;
#define PH(...) do { if (pc >= lo && pc < hi) { __VA_ARGS__; if (pc + 1 < hi) grid.sync(); } ++pc; } while (0)
    unsigned char* ws = P.ws;
    bf16* HN = (bf16*)(ws + WS_HN); bf16* PROJ = (bf16*)(ws + WS_PROJ); bf16* XACT = (bf16*)(ws + WS_XACT); bf16* MIX = (bf16*)(ws + WS_MIX);
    float* MB = (float*)(ws + WS_M); bf16* YF = (bf16*)(ws + WS_M); bf16* YB = (bf16*)(ws + WS_M + 32 * MiB);
    float* ST = (float*)(ws + WS_ST); float* DEC = (float*)(ws + WS_DEC); float* DTV = (float*)(ws + WS_DT);
    const float* NG = P.in[2];

    PH(p0_weights(P, lds));
#pragma unroll 1
    for (int slab = 0; slab < NSLAB; ++slab) {
        const float* xin = (slab < 2) ? P.in[0] + (size_t)slab * MS * D : P.in[1];
        float* X = P.out + (size_t)slab * MS * D;
        const int S = (slab < 2) ? 2048 : 16384, nseq = MS / S, nseg = S / 512;
        PH(p_init(xin, X, HN, NG));
#pragma unroll 1
        for (int l = 0; l < DEPTH; ++l) {
            const int j = l >> 1; const float* g = NG + (size_t)l * 4 * D;
            if ((l & 1) == 0) {
                PH({ pg8::Gemm gm{HN, (const bf16*)(ws + WS_EVIN + j * SZ_EVIN), MS, EV_N, D}; pg8::StaticOrder so; so.init(MS, EV_N, gridDim.x, blockIdx.x);
                     pg8::EpiBf16 ep{PROJ, EV_N}; pg8::gemm_phase<pg8::EpiBf16, pg8::StaticOrder, true, true>(lds, gm, so, ep); });
                PH({ p_attn(lds, PROJ, MIX, P.in[3], P.in[5] + j * 8, S);
                     p_conv(PROJ, XACT, DTV, P.in[6] + (size_t)j * 5 * 1280, P.in[7] + j * 1280, P.in[9] + j * 32, S); });
                PH(ssd_scan<false>(lds, XACT, DTV, P.in[8] + j * 32, ST, DEC, YF, YB));
                PH(ssd_passB(ST, DEC, nseq, nseg));
                PH(ssd_scan<true>(lds, XACT, DTV, P.in[8] + j * 32, ST, DEC, YF, YB));
                PH(ssd_post(PROJ, XACT, YF, YB, MIX, P.in[10] + j * 16, P.in[11] + j * 1024));
                PH({ pg8::Gemm gm{MIX, (const bf16*)(ws + WS_EVOUT + j * SZ_EVOUT), MS, D, MIXK}; pg8::StaticOrder so; so.init(MS, D, gridDim.x, blockIdx.x);
                     pg8::EpiF32 ep{MB, D}; pg8::gemm_phase<pg8::EpiF32, pg8::StaticOrder, true, true>(lds, gm, so, ep); });
            } else {
                PH({ pg8::Gemm gm{HN, (const bf16*)(ws + WS_ODIN + j * SZ_ODIN), MS, OD_N, D}; pg8::StaticOrder so; so.init(MS, OD_N, gridDim.x, blockIdx.x);
                     pg8::EpiBf16 ep{PROJ, OD_N}; pg8::gemm_phase<pg8::EpiBf16, pg8::StaticOrder, true, true>(lds, gm, so, ep); });
                PH(hg_scan<false>(lds, PROJ, P.in[14], j, ST, DEC, YF, YB));
                PH(hg_passB(ST, DEC, nseq, nseg));
                PH(hg_scan<true>(lds, PROJ, P.in[14], j, ST, DEC, YF, YB));
                PH(hg_post(PROJ, YF, YB, MIX, P.in[15] + j * 128));
                PH({ pg8::Gemm gm{MIX, (const bf16*)(ws + WS_ODOUT + j * SZ_ODOUT), MS, D, D}; pg8::StaticOrder so; so.init(MS, D, gridDim.x, blockIdx.x);
                     pg8::EpiF32 ep{MB, D}; pg8::gemm_phase<pg8::EpiF32, pg8::StaticOrder, true, true>(lds, gm, so, ep); });
            }
            PH(p_resnorm(X, MB, HN, g + D, g + 2 * D));
            PH({ pg8::Gemm gm{HN, (const bf16*)(ws + WS_FFGU + l * SZ_FFGU), MS, FF2, D}; pg8::StaticOrder so; so.init(MS, FF2, gridDim.x, blockIdx.x);
                 pg8::EpiSwiGLU ep{PROJ, FF}; pg8::gemm_phase<pg8::EpiSwiGLU, pg8::StaticOrder, true, true>(lds, gm, so, ep); });
            PH({ pg8::Gemm gm{PROJ, (const bf16*)(ws + WS_FFD + l * SZ_FFD), MS, D, FF}; pg8::StaticOrder so; so.init(MS, D, gridDim.x, blockIdx.x);
                 pg8::EpiF32 ep{MB, D}; pg8::gemm_phase<pg8::EpiF32, pg8::StaticOrder, true, true>(lds, gm, so, ep); });
            PH(p_resnorm(X, MB, HN, g + 3 * D, (l + 1 < DEPTH) ? g + 4 * D : nullptr));
        }
    }
#undef PH
}

#ifndef N_LAUNCH_MODE
#define N_LAUNCH_MODE 0
#endif
extern "C" void kernel_launch(void* const* d_in, const int* in_sizes, int n_in, void* d_out, int out_size, void* d_ws, size_t ws_size, hipStream_t stream) {
    static int grid = 0;
    if (grid == 0) {
        if (n_in != 20 || ws_size < WS_END) { fprintf(stderr, "kernel_launch: unexpected n_in %d / ws %zu\n", n_in, ws_size); grid = -1; return; }
        int dev = 0, cus = 0, per_cu = 0;
        hipGetDevice(&dev); hipDeviceGetAttribute(&cus, hipDeviceAttributeMultiprocessorCount, dev);
        hipFuncSetAttribute((const void*)mega, hipFuncAttributeMaxDynamicSharedMemorySize, LDS_BYTES);
        hipOccupancyMaxActiveBlocksPerMultiprocessor(&per_cu, (const void*)mega, 512, LDS_BYTES);
        (void)hipGetLastError();
        if (per_cu < 1) per_cu = 1;
        grid = cus * 1;
        if (grid > 256) grid = 256;
    }
    if (grid < 0) return;
    Params p{};
    for (int i = 0; i < 20; ++i) p.in[i] = (const float*)d_in[i];
    p.out = (float*)d_out; p.ws = (unsigned char*)d_ws;
#if N_LAUNCH_MODE == 1
    p.ph_lo = 0; p.ph_hi = N_PHASES;
    void* args[] = {&p};
    hipError_t e = hipLaunchCooperativeKernel((const void*)mega, dim3(grid), dim3(512), args, LDS_BYTES, stream);
    if (e != hipSuccess) fprintf(stderr, "cooperative launch failed: %s (grid %d)\n", hipGetErrorString(e), grid);
#else
    for (int ph = 0; ph < N_PHASES; ++ph) { p.ph_lo = ph; p.ph_hi = ph + 1; hipLaunchKernelGGL(mega, dim3(grid), dim3(512), LDS_BYTES, stream, p); }
#endif
}
```

```cpp
#include <hip/hip_runtime.h>
#include <hip/hip_cooperative_groups.h>
#include <cstdio>
#include <cstdint>
namespace cg = cooperative_groups;
__device__ __forceinline__ int tid_opaque() { int t = threadIdx.x; asm volatile("" : "+v"(t)); return t; }
namespace pg8 {
#define PG8_LAS __attribute__((address_space(3)))
typedef unsigned short bf16_t;
typedef short bf16x8 __attribute__((ext_vector_type(8)));
typedef float f32x4 __attribute__((ext_vector_type(4)));
typedef unsigned u32x4 __attribute__((ext_vector_type(4)));
constexpr int BM = 256, BK = 64, HALF = 128, HTB = HALF * BK * 2  , STAGE_BYTES = 8 * HTB, NXCD = 8, WGM = 8;

__host__ __device__ __forceinline__ int lds_byte(int r, int c) { const int st = (r >> 4) * 2 + (c >> 5), rr = r & 15, cc = c & 31, ob = rr * 64 + cc * 2; return st * 1024 + (ob ^ (((ob >> 9) & 1) << 5)); }
__host__ __device__ __forceinline__ void stage_rc(int b, int& R, int& C) { const int st = b / 1024, sb = b % 1024, swz = sb ^ (((sb >> 9) & 1) << 5); R = (st >> 1) * 16 + swz / 64; C = (st & 1) * 32 + (swz % 64) / 2; }
__host__ __device__ __forceinline__ int perm32(int rho) { const int n = rho >> 4, i = rho & 15; return 8 * (i >> 2) + 4 * n + (i & 3); }

struct Unit { int pm, pn; };
struct Gemm { const bf16_t* A; const bf16_t* Bt; int M, N, K; };

struct StaticOrder {
    int nM, nN, nwg, G, c;
    __host__ __device__ void init(int M, int N, int G_, int c_) { nM = M / BM; nN = N / BM; nwg = nM * nN; G = G_; c = c_; }
    __host__ __device__ bool next(int i, Unit& u) const {
        const long L = (long)i * G + c; if (L >= nwg) return false;
        int wgid = (int)L; { const int q = nwg / NXCD, r = nwg % NXCD, xcd = wgid % NXCD, off = wgid / NXCD; wgid = (xcd < r ? xcd * (q + 1) : r * (q + 1) + (xcd - r) * q) + off; }
        const int nig = WGM * nN, gid = wgid / nig, fm = gid * WGM, gsz = (nM - fm) < WGM ? (nM - fm) : WGM;
        u.pm = fm + ((wgid % nig) % gsz); u.pn = (wgid % nig) / gsz; return true;
    }
    __device__ __forceinline__ void a_ready(const Unit&) const {}
    __device__ __forceinline__ void done(const Unit&) const {}
};

__device__ __forceinline__ unsigned cvt_pk_bf16(float lo, float hi) { unsigned r; asm volatile("v_cvt_pk_bf16_f32 %0, %1, %2" : "=v"(r) : "v"(lo), "v"(hi)); return r; }
struct EpiBf16 {
    static constexpr bool PERM = true, AFTER_DRAIN = false;
    bf16_t* O; int ldc;
    __device__ __forceinline__ void operator()(const f32x4 (&acc)[2][2][4][2], const Unit& u, int wr, int wc, int fr, int fq) const {
        const int row0 = u.pm * BM + wr * 64 + fr; const int col0 = u.pn * BM + wc * 32 + 8 * fq;
#pragma unroll
        for (int ai = 0; ai < 2; ++ai)
#pragma unroll
            for (int m = 0; m < 4; ++m) { bf16_t* rowp = O + (size_t)(row0 + ai * HALF + m * 16) * ldc + col0;
#pragma unroll
                for (int bj = 0; bj < 2; ++bj) { const f32x4 v0 = acc[ai][bj][m][0], v1 = acc[ai][bj][m][1];
                    u32x4 w; w.x = cvt_pk_bf16(v0[0], v0[1]); w.y = cvt_pk_bf16(v0[2], v0[3]); w.z = cvt_pk_bf16(v1[0], v1[1]); w.w = cvt_pk_bf16(v1[2], v1[3]);
                    *(u32x4*)(rowp + bj * HALF) = w; } }
    }
};
struct EpiF32 {
    static constexpr bool PERM = false, AFTER_DRAIN = false;
    float* O; int ldc;
    __device__ __forceinline__ void operator()(const f32x4 (&acc)[2][2][4][2], const Unit& u, int wr, int wc, int fr, int fq) const {
        const int row0 = u.pm * BM + wr * 64 + fr; const int col0 = u.pn * BM + wc * 32 + 4 * fq;
#pragma unroll
        for (int ai = 0; ai < 2; ++ai)
#pragma unroll
            for (int m = 0; m < 4; ++m) { float* rowp = O + (size_t)(row0 + ai * HALF + m * 16) * ldc + col0;
#pragma unroll
                for (int bj = 0; bj < 2; ++bj)
#pragma unroll
                    for (int n = 0; n < 2; ++n) *(f32x4*)(rowp + bj * HALF + 16 * n) = acc[ai][bj][m][n]; }
    }
};
struct EpiSwiGLU {
    static constexpr bool PERM = true, AFTER_DRAIN = false;
    bf16_t* O; int ldc;
    __device__ __forceinline__ void operator()(const f32x4 (&acc)[2][2][4][2], const Unit& u, int wr, int wc, int fr, int fq) const {
        const int row0 = u.pm * BM + wr * 64 + fr; const int col0 = u.pn * HALF + wc * 32 + 8 * fq;
#pragma unroll
        for (int ai = 0; ai < 2; ++ai)
#pragma unroll
            for (int m = 0; m < 4; ++m) { bf16_t* rowp = O + (size_t)(row0 + ai * HALF + m * 16) * ldc + col0;
                float r[8];
#pragma unroll
                for (int n = 0; n < 2; ++n)
#pragma unroll
                    for (int e = 0; e < 4; ++e) { const float g = acc[ai][0][m][n][e], up = acc[ai][1][m][n][e]; r[n * 4 + e] = g / (1.f + __expf(-g)) * up; }
                u32x4 w; w.x = cvt_pk_bf16(r[0], r[1]); w.y = cvt_pk_bf16(r[2], r[3]); w.z = cvt_pk_bf16(r[4], r[5]); w.w = cvt_pk_bf16(r[6], r[7]);
                *(u32x4*)rowp = w; }
    }
};

template <class Epi, class Sched, bool ALIGN_EPI = false, bool SP2 = false>
__device__ __forceinline__ void gemm_phase(PG8_LAS unsigned char* lds, const Gemm g, const Sched& S, const Epi& E) {
    const int tid = tid_opaque(), wid = __builtin_amdgcn_readfirstlane(tid >> 6), lane = tid & 63, wr = wid >> 2, wc = wid & 3, fr = lane & 15, fq = lane >> 4;
    const int K = g.K, nt = K / BK;
    unsigned voffA[2], voffB[2];
#pragma unroll
    for (int i = 0; i < 2; ++i) { int R, C; stage_rc(tid * 16 + i * 8192, R, C); const int Rb = Epi::PERM ? ((R & ~31) + perm32(R & 31)) : R;
        voffA[i] = (unsigned)(R * K + C) * 2u; voffB[i] = (unsigned)(Rb * K + C) * 2u; }
    const size_t kstep = (size_t)(BK * 2);
    const size_t hstep = (size_t)HALF * K * 2;
    const size_t tstep = 2 * hstep;
    const unsigned ldsw = (unsigned)wid * 1024u;
    const int aoff = lds_byte(wr * 64 + fr, fq * 8), boff = lds_byte(wc * 32 + fr, fq * 8);
#define PG8_SA(b, h) (((b) * 2 + (h)) * HTB)
#define PG8_SB(b, h) ((4 + (b) * 2 + (h)) * HTB)
#define PG8_STAGE(bufoff, gbase, voff) do { _Pragma("unroll") for (int _i = 0; _i < 2; ++_i) \
        __builtin_amdgcn_global_load_lds((const unsigned*)((const char*)(gbase) + (voff)[_i]), (PG8_LAS unsigned*)(lds + (bufoff) + ldsw + _i * 8192), 16, 0, 0); } while (0)
#define PG8_LDA(dst, b, h) do { _Pragma("unroll") for (int m = 0; m < 4; ++m) _Pragma("unroll") for (int k = 0; k < 2; ++k) dst[m][k] = *(const PG8_LAS bf16x8*)(lds + PG8_SA(b, h) + aoff + m * 2048 + k * 1024); } while (0)
#define PG8_LDB(dst, b, h) do { _Pragma("unroll") for (int n = 0; n < 2; ++n) _Pragma("unroll") for (int k = 0; k < 2; ++k) dst[n][k] = *(const PG8_LAS bf16x8*)(lds + PG8_SB(b, h) + boff + n * 2048 + k * 1024); } while (0)
#define PG8_MMA(ai, bj, At, Bt) do { __builtin_amdgcn_s_setprio(1); _Pragma("unroll") for (int m = 0; m < 4; ++m) _Pragma("unroll") for (int n = 0; n < 2; ++n) _Pragma("unroll") for (int k = 0; k < 2; ++k) \
        acc[ai][bj][m][n] = __builtin_amdgcn_mfma_f32_16x16x32_bf16(Bt[n][k], At[m][k], acc[ai][bj][m][n], 0, 0, 0); __builtin_amdgcn_s_setprio(0); } while (0)
#define PG8_WAIT_V(n) asm volatile("s_waitcnt vmcnt(" #n ")" ::: "memory")
#define PG8_WAIT_L(n) asm volatile("s_waitcnt lgkmcnt(" #n ")" ::: "memory")
#define PG8_BAR __builtin_amdgcn_s_barrier()
#define PG8_SCHED __builtin_amdgcn_sched_barrier(0)
    Unit cur, nxt; int ui = 0;
    if (!S.next(0, cur)) return;
    f32x4 acc[2][2][4][2];
#pragma unroll
    for (int a = 0; a < 2; ++a)
#pragma unroll
        for (int b = 0; b < 2; ++b)
#pragma unroll
            for (int m = 0; m < 4; ++m)
#pragma unroll
                for (int n = 0; n < 2; ++n) acc[a][b][m][n] = (f32x4){0.f, 0.f, 0.f, 0.f};
    bf16x8 At[4][2], B0[2][2], B1[2][2];
    const char* cA = (const char*)g.A + (size_t)cur.pm * tstep; const char* cB = (const char*)g.Bt + (size_t)cur.pn * tstep;
    S.a_ready(cur);
    if constexpr (SP2) {
        PG8_STAGE(PG8_SB(0, 0), cB, voffB); PG8_STAGE(PG8_SB(0, 1), cB + hstep, voffB); PG8_STAGE(PG8_SA(0, 0), cA, voffA); PG8_STAGE(PG8_SA(0, 1), cA + hstep, voffA);
        if (wr == 1) PG8_BAR;
        PG8_WAIT_V(2); PG8_BAR;
        PG8_STAGE(PG8_SB(1, 0), cB + kstep, voffB); PG8_STAGE(PG8_SA(1, 0), cA + kstep, voffA); PG8_STAGE(PG8_SB(1, 1), cB + hstep + kstep, voffB);
        PG8_WAIT_V(6); PG8_BAR;
    } else {
        PG8_STAGE(PG8_SB(0, 0), cB, voffB); PG8_STAGE(PG8_SA(0, 0), cA, voffA); PG8_STAGE(PG8_SB(0, 1), cB + hstep, voffB); PG8_STAGE(PG8_SA(0, 1), cA + hstep, voffA);
        if (wr == 1) PG8_BAR;
        PG8_WAIT_V(4); PG8_BAR;
        PG8_STAGE(PG8_SB(1, 0), cB + kstep, voffB); PG8_STAGE(PG8_SA(1, 0), cA + kstep, voffA); PG8_STAGE(PG8_SB(1, 1), cB + hstep + kstep, voffB);
        PG8_WAIT_V(6); PG8_BAR;
    }
    for (;;) {
        const bool has_next = S.next(ui + 1, nxt);
        const char* nA = has_next ? (const char*)g.A + (size_t)nxt.pm * tstep : cA; const char* nB = has_next ? (const char*)g.Bt + (size_t)nxt.pn * tstep : cB;
        for (int t = 0; t < nt; t += 2) {
            const bool last = (t == nt - 2);
            const char* a1 = cA + (size_t)(t + 1) * kstep;
            const char* a2 = last ? nA : cA + (size_t)(t + 2) * kstep; const char* b2 = last ? nB : cB + (size_t)(t + 2) * kstep;
            const char* a3 = a2 + kstep; const char* b3 = b2 + kstep;
            if (last && has_next) S.a_ready(nxt);
            if constexpr (SP2) {
            PG8_LDB(B0, 0, 0); PG8_LDB(B1, 0, 1); PG8_SCHED; PG8_LDA(At, 0, 0); PG8_STAGE(PG8_SA(1, 1), a1 + hstep, voffA);
            PG8_WAIT_V(8); PG8_WAIT_L(0); PG8_BAR; PG8_MMA(0, 0, At, B0); PG8_MMA(0, 1, At, B1); PG8_BAR; PG8_SCHED;
            PG8_LDA(At, 0, 1); PG8_STAGE(PG8_SB(0, 0), b2, voffB); PG8_STAGE(PG8_SB(0, 1), b2 + hstep, voffB); PG8_STAGE(PG8_SA(0, 0), a2, voffA);
            PG8_WAIT_V(8); PG8_WAIT_L(0); PG8_BAR; PG8_MMA(1, 0, At, B0); PG8_MMA(1, 1, At, B1); PG8_BAR; PG8_SCHED;
            PG8_LDB(B0, 1, 0); PG8_LDB(B1, 1, 1); PG8_SCHED; PG8_LDA(At, 1, 0); PG8_STAGE(PG8_SA(0, 1), a2 + hstep, voffA);
            PG8_WAIT_V(8); PG8_WAIT_L(0); PG8_BAR; PG8_MMA(0, 0, At, B0); PG8_MMA(0, 1, At, B1); PG8_BAR; PG8_SCHED;
            PG8_LDA(At, 1, 1); PG8_STAGE(PG8_SB(1, 0), b3, voffB); PG8_STAGE(PG8_SB(1, 1), b3 + hstep, voffB); PG8_STAGE(PG8_SA(1, 0), a3, voffA);
            PG8_WAIT_V(8); PG8_WAIT_L(0); PG8_BAR; PG8_MMA(1, 0, At, B0); PG8_MMA(1, 1, At, B1); PG8_BAR; PG8_SCHED;
            } else {
            PG8_LDB(B0, 0, 0); PG8_SCHED; PG8_LDA(At, 0, 0); PG8_STAGE(PG8_SA(1, 1), a1 + hstep, voffA);
            PG8_WAIT_L(8); PG8_BAR; PG8_WAIT_L(0); PG8_MMA(0, 0, At, B0); PG8_BAR; PG8_SCHED;
            PG8_LDB(B1, 0, 1); PG8_STAGE(PG8_SB(0, 0), b2, voffB);
            PG8_BAR; PG8_WAIT_L(0); PG8_MMA(0, 1, At, B1); PG8_BAR;
            PG8_LDA(At, 0, 1); PG8_STAGE(PG8_SA(0, 0), a2, voffA);
            PG8_BAR; PG8_WAIT_L(0); PG8_MMA(1, 0, At, B0); PG8_BAR; PG8_SCHED;
            PG8_STAGE(PG8_SB(0, 1), b2 + hstep, voffB);
            PG8_WAIT_V(6); PG8_BAR; PG8_MMA(1, 1, At, B1); PG8_BAR;
            PG8_LDB(B0, 1, 0); PG8_SCHED; PG8_LDA(At, 1, 0); PG8_STAGE(PG8_SA(0, 1), a2 + hstep, voffA);
            PG8_WAIT_L(8); PG8_BAR; PG8_WAIT_L(0); PG8_MMA(0, 0, At, B0); PG8_BAR; PG8_SCHED;
            PG8_LDB(B1, 1, 1); PG8_STAGE(PG8_SB(1, 0), b3, voffB);
            PG8_BAR; PG8_WAIT_L(0); PG8_MMA(0, 1, At, B1); PG8_BAR;
            PG8_LDA(At, 1, 1); PG8_STAGE(PG8_SA(1, 0), a3, voffA);
            PG8_BAR; PG8_WAIT_L(0); PG8_MMA(1, 0, At, B0); PG8_BAR; PG8_SCHED;
            PG8_STAGE(PG8_SB(1, 1), b3 + hstep, voffB);
            PG8_WAIT_V(6); PG8_BAR; PG8_MMA(1, 1, At, B1); PG8_BAR;
            }
        }
        if constexpr (ALIGN_EPI) { if (wr == 0) PG8_BAR; }
        if constexpr (!Epi::AFTER_DRAIN) { E(acc, cur, wr, wc, fr, fq); S.done(cur); }
        if (!has_next) break;
#pragma unroll
        for (int a = 0; a < 2; ++a)
#pragma unroll
            for (int b = 0; b < 2; ++b)
#pragma unroll
                for (int m = 0; m < 4; ++m)
#pragma unroll
                    for (int n = 0; n < 2; ++n) acc[a][b][m][n] = (f32x4){0.f, 0.f, 0.f, 0.f};
        cur = nxt; cA = nA; cB = nB; ++ui;
        if constexpr (ALIGN_EPI) { if (wr == 1) PG8_BAR; }
    }
    PG8_WAIT_V(0);
    if constexpr (!ALIGN_EPI) { if (wr == 0) PG8_BAR; }
    PG8_BAR;
    if constexpr (Epi::AFTER_DRAIN) { E.fused(acc, cur, wr, wc, fr, fq, lds, wid, lane); S.done(cur); }
#undef PG8_SA
#undef PG8_SB
#undef PG8_STAGE
#undef PG8_LDA
#undef PG8_LDB
#undef PG8_MMA
#undef PG8_WAIT_V
#undef PG8_WAIT_L
#undef PG8_BAR
#undef PG8_SCHED
}
}
#define LAS __attribute__((address_space(3)))
typedef unsigned short bf16;
typedef LAS unsigned char* lptr;
typedef short bf16x8 __attribute__((ext_vector_type(8)));
typedef float f32x4 __attribute__((ext_vector_type(4)));
typedef unsigned u32x4 __attribute__((ext_vector_type(4)));
typedef unsigned u32x2 __attribute__((ext_vector_type(2)));

constexpr int D = 1024, MS = 16384, NSLAB = 3, DEPTH = 4;
constexpr int EV_N = 3328, EV_NREAL = 3104, OD_N = 5120, FF = 2816, FF2 = 5632, MIXK = 1536;
constexpr float EPS = 1e-6f;
constexpr size_t MiB = 1u << 20;
constexpr size_t WS_EVIN = 1 * MiB;
constexpr size_t SZ_EVIN = (size_t)EV_N * D * 2;
constexpr size_t WS_EVOUT = WS_EVIN + 2 * SZ_EVIN;
constexpr size_t SZ_EVOUT = (size_t)D * MIXK * 2;
constexpr size_t WS_ODIN = WS_EVOUT + 2 * SZ_EVOUT;
constexpr size_t SZ_ODIN = (size_t)OD_N * D * 2;
constexpr size_t WS_ODOUT = WS_ODIN + 2 * SZ_ODIN;
constexpr size_t SZ_ODOUT = (size_t)D * D * 2;
constexpr size_t WS_FFGU = WS_ODOUT + 2 * SZ_ODOUT;
constexpr size_t SZ_FFGU = (size_t)FF2 * D * 2;
constexpr size_t WS_FFD = WS_FFGU + 4 * SZ_FFGU;
constexpr size_t SZ_FFD = (size_t)D * FF * 2;
constexpr size_t WS_WEND = WS_FFD + 4 * SZ_FFD;
static_assert(WS_WEND <= 112 * MiB, "weights region");
constexpr size_t WS_HN = 112 * MiB;
constexpr size_t WS_PROJ = 144 * MiB;
constexpr size_t WS_XACT = WS_PROJ + 104 * MiB;
constexpr size_t WS_MIX = 304 * MiB;
constexpr size_t WS_M = 352 * MiB;
constexpr size_t WS_ST = 416 * MiB;
constexpr size_t WS_DEC = 450 * MiB;
constexpr size_t WS_DT = 452 * MiB;
constexpr size_t WS_END = 456 * MiB;

constexpr int LDS_BYTES = 147456;

__device__ __forceinline__ unsigned f2bf(float f) { unsigned u = __builtin_bit_cast(unsigned, f); return (u + 0x7fffu + ((u >> 16) & 1u)) >> 16; }
__device__ __forceinline__ unsigned pk2(float lo, float hi) { return f2bf(lo) | (f2bf(hi) << 16); }
__device__ __forceinline__ float bf2f(bf16 b) { return __builtin_bit_cast(float, (unsigned)b << 16); }
__device__ __forceinline__ float bflo(unsigned u) { return __builtin_bit_cast(float, u << 16); }
__device__ __forceinline__ float bfhi(unsigned u) { return __builtin_bit_cast(float, u & 0xffff0000u); }
__device__ __forceinline__ float wave_sum(float v) {
#pragma unroll
    for (int o = 1; o < 64; o <<= 1) v += __shfl_xor(v, o);
    return v;
}
__device__ __forceinline__ float silu_f(float x) { return x / (1.f + __expf(-x)); }
__device__ __forceinline__ bf16x8 ldfrag(lptr base, int row, int strideB, int kelem) { return *(const LAS bf16x8*)(base + row * strideB + kelem * 2); }
__device__ __forceinline__ void unpack8(const u32x4 v, float (&f)[8]) {
    f[0] = bflo(v.x); f[1] = bfhi(v.x); f[2] = bflo(v.y); f[3] = bfhi(v.y); f[4] = bflo(v.z); f[5] = bfhi(v.z); f[6] = bflo(v.w); f[7] = bfhi(v.w);
}
#define MFMA16(a, b, c) __builtin_amdgcn_mfma_f32_16x16x32_bf16((a), (b), (c), 0, 0, 0)
#define LDSWAIT() asm volatile("s_waitcnt lgkmcnt(0)" ::: "memory")

struct Params {
    const float* in[20];
    float* out;
    unsigned char* ws;
    int ph_lo, ph_hi;
};

__device__ __forceinline__ void tr_matrix(const float* __restrict__ W, int K, int N, bf16* WT, int mode, int gw, int NGW, LAS float* scr, int lane) {
    const int nnb = N / 32, items = (K / 64) * nnb;
    for (int it = gw; it < items; it += NGW) {
        const int kb = it / nnb, nb = it % nnb, k0 = 64 * kb, n0 = 32 * nb;
        const int drow0 = (mode == 0) ? n0 : (256 * (n0 >> 7) + (n0 & 127) + (mode == 2 ? 128 : 0));
#pragma unroll 8
        for (int i = 0; i < 32; ++i) { const int kk = 2 * i + (lane >> 5); scr[kk * 33 + (lane & 31)] = W[(size_t)(k0 + kk) * N + n0 + (lane & 31)]; }
        LDSWAIT();
        const int c = lane & 7;
#pragma unroll
        for (int j = 0; j < 4; ++j) { const int n = (lane >> 3) + 8 * j; const LAS float* s = scr + (8 * c) * 33 + n;
            u32x4 o; o.x = pk2(s[0 * 33], s[1 * 33]); o.y = pk2(s[2 * 33], s[3 * 33]); o.z = pk2(s[4 * 33], s[5 * 33]); o.w = pk2(s[6 * 33], s[7 * 33]);
            *(u32x4*)(WT + (size_t)(drow0 + n) * K + k0 + 8 * c) = o; }
        LDSWAIT();
    }
}
__device__ __forceinline__ void p0_weights(const Params& P, lptr lds) {
    const int tid = tid_opaque(), lane = tid & 63, wave = tid >> 6;
    LAS float* scr = (LAS float*)(lds + wave * 16384);
    const int gw = blockIdx.x * 8 + wave, NGW = gridDim.x * 8;
    unsigned char* ws = P.ws;
    for (int j = 0; j < 2; ++j) {
        tr_matrix(P.in[4] + (size_t)j * D * EV_NREAL, D, EV_NREAL, (bf16*)(ws + WS_EVIN + j * SZ_EVIN), 0, gw, NGW, scr, lane);
        tr_matrix(P.in[12] + (size_t)j * MIXK * D, MIXK, D, (bf16*)(ws + WS_EVOUT + j * SZ_EVOUT), 0, gw, NGW, scr, lane);
        tr_matrix(P.in[13] + (size_t)j * D * OD_N, D, OD_N, (bf16*)(ws + WS_ODIN + j * SZ_ODIN), 0, gw, NGW, scr, lane);
        tr_matrix(P.in[16] + (size_t)j * D * D, D, D, (bf16*)(ws + WS_ODOUT + j * SZ_ODOUT), 0, gw, NGW, scr, lane);
    }
    for (int l = 0; l < 4; ++l) {
        tr_matrix(P.in[17] + (size_t)l * D * FF, D, FF, (bf16*)(ws + WS_FFGU + l * SZ_FFGU), 1, gw, NGW, scr, lane);
        tr_matrix(P.in[18] + (size_t)l * D * FF, D, FF, (bf16*)(ws + WS_FFGU + l * SZ_FFGU), 2, gw, NGW, scr, lane);
        tr_matrix(P.in[19] + (size_t)l * FF * D, FF, D, (bf16*)(ws + WS_FFD + l * SZ_FFD), 0, gw, NGW, scr, lane);
    }
    const int gt = blockIdx.x * 512 + tid, NT = gridDim.x * 512;
    for (int i = gt; i < 2 * 224 * 128; i += NT) { const int j = i / (224 * 128), r = i % (224 * 128);
        *(u32x4*)(ws + WS_EVIN + j * SZ_EVIN + (size_t)EV_NREAL * D * 2 + (size_t)r * 16) = (u32x4){0u, 0u, 0u, 0u}; }
}

__device__ __forceinline__ void p_init(const float* __restrict__ xin, float* xo, bf16* hn, const float* __restrict__ g) {
    const int tid = tid_opaque(), lane = tid & 63, wave = tid >> 6;
    const int gw = blockIdx.x * 8 + wave, NGW = gridDim.x * 8;
    for (int r = gw; r < MS; r += NGW) {
        const f32x4* xr = (const f32x4*)(xin + (size_t)r * D) + lane; f32x4 v[4]; float s = 0.f;
#pragma unroll
        for (int j = 0; j < 4; ++j) { v[j] = xr[64 * j]; s += (v[j].x * v[j].x + v[j].y * v[j].y) + (v[j].z * v[j].z + v[j].w * v[j].w); }
        const float rs = rsqrtf(wave_sum(s) * (1.f / D) + EPS);
        f32x4* xw = (f32x4*)(xo + (size_t)r * D) + lane; u32x2* ho = (u32x2*)(hn + (size_t)r * D) + lane; const f32x4* gg = (const f32x4*)g + lane;
#pragma unroll
        for (int j = 0; j < 4; ++j) { xw[64 * j] = v[j]; const f32x4 gv = gg[64 * j];
            u32x2 o; o.x = pk2(v[j].x * rs * gv.x, v[j].y * rs * gv.y); o.y = pk2(v[j].z * rs * gv.z, v[j].w * rs * gv.w); ho[64 * j] = o; }
    }
}
__device__ __forceinline__ void p_resnorm(float* x, const float* __restrict__ m, bf16* hn, const float* __restrict__ gpost, const float* __restrict__ gpre) {
    const int tid = tid_opaque(), lane = tid & 63, wave = tid >> 6;
    const int gw = blockIdx.x * 8 + wave, NGW = gridDim.x * 8;
    for (int r = gw; r < MS; r += NGW) {
        const f32x4* mr = (const f32x4*)(m + (size_t)r * D) + lane; f32x4* xr = (f32x4*)(x + (size_t)r * D) + lane;
        f32x4 mv[4], xv[4]; float s = 0.f;
#pragma unroll
        for (int j = 0; j < 4; ++j) { mv[j] = mr[64 * j]; xv[j] = xr[64 * j]; s += (mv[j].x * mv[j].x + mv[j].y * mv[j].y) + (mv[j].z * mv[j].z + mv[j].w * mv[j].w); }
        const float rs = rsqrtf(wave_sum(s) * (1.f / D) + EPS); float s2 = 0.f;
        const f32x4* gp = (const f32x4*)gpost + lane;
#pragma unroll
        for (int j = 0; j < 4; ++j) { const f32x4 gv = gp[64 * j]; xv[j] = xv[j] + mv[j] * rs * gv; xr[64 * j] = xv[j];
            s2 += (xv[j].x * xv[j].x + xv[j].y * xv[j].y) + (xv[j].z * xv[j].z + xv[j].w * xv[j].w); }
        if (gpre) {
            const float rs2 = rsqrtf(wave_sum(s2) * (1.f / D) + EPS);
            u32x2* ho = (u32x2*)(hn + (size_t)r * D) + lane; const f32x4* gg = (const f32x4*)gpre + lane;
#pragma unroll
            for (int j = 0; j < 4; ++j) { const f32x4 gv = gg[64 * j];
                u32x2 o; o.x = pk2(xv[j].x * rs2 * gv.x, xv[j].y * rs2 * gv.y); o.y = pk2(xv[j].z * rs2 * gv.z, xv[j].w * rs2 * gv.w); ho[64 * j] = o; }
        }
    }
}

__device__ __forceinline__ int t5_bucket(int rel) {
    const int n = rel < 0 ? -rel : rel;
    const int mag = n < 8 ? n : 8 + (n >= 12) + (n >= 16) + (n >= 23) + (n >= 32) + (n >= 46) + (n >= 64) + (n >= 91);
    return (rel > 0 ? 16 : 0) + mag;
}
__device__ __forceinline__ void p_attn(lptr lds, const bf16* __restrict__ proj, bf16* mix, const float* __restrict__ t5, const float* __restrict__ sink, int S) {
    const int tid = tid_opaque(), lane = tid & 63, w = tid >> 6, r16 = lane & 15, q4 = lane >> 4;
    constexpr int KSB = 144, VSB = 784;
    lptr sK = lds, sVT = lds + 55296; LAS float* sBias = (LAS float*)(lds + 105472);
    const int bps = S / 128;
    for (int u = blockIdx.x; u < 256; u += gridDim.x) {
        const int g = u & 1, qb = u >> 1, n = qb % bps, row_q0 = qb * 128;
        __syncthreads();
        for (int i = tid; i < 4 * 257; i += 512) { const int r = i / 257, d = i % 257; sBias[r * 260 + d] = t5[t5_bucket(d - 128) * 8 + 4 * g + r]; }
        for (int c = tid; c < 3072; c += 512) {
            const int key = c >> 3, part = c & 7; const int kpos = n * 128 - 128 + key;
            u32x4 kv = (u32x4){0u, 0u, 0u, 0u}, vv = kv;
            if (kpos >= 0 && kpos < S) { const bf16* pr = proj + (size_t)(row_q0 - 128 + key) * EV_N + g * 64 + 8 * part;
                kv = *(const u32x4*)(pr + 512); vv = *(const u32x4*)(pr + 640); }
            *(LAS u32x4*)(sK + key * KSB + part * 16) = kv;
            LAS bf16* vt = (LAS bf16*)(sVT + (8 * part) * VSB) + key;
            vt[0 * (VSB / 2)] = (bf16)(vv.x & 0xffffu); vt[1 * (VSB / 2)] = (bf16)(vv.x >> 16); vt[2 * (VSB / 2)] = (bf16)(vv.y & 0xffffu); vt[3 * (VSB / 2)] = (bf16)(vv.y >> 16);
            vt[4 * (VSB / 2)] = (bf16)(vv.z & 0xffffu); vt[5 * (VSB / 2)] = (bf16)(vv.z >> 16); vt[6 * (VSB / 2)] = (bf16)(vv.w & 0xffffu); vt[7 * (VSB / 2)] = (bf16)(vv.w >> 16);
        }
        __syncthreads();
        const int r = w >> 1, h = 4 * g + r, qh = w & 1;
        const float snk = sink[h];
        for (int qg = 0; qg < 4; ++qg) {
            const int qi = 64 * qh + 16 * qg + r16;
            const bf16* qp = proj + (size_t)(row_q0 + qi) * EV_N + h * 64 + 8 * q4;
            const bf16x8 bq0 = *(const bf16x8*)qp, bq1 = *(const bf16x8*)(qp + 32);
            f32x4 sc[24];
#pragma unroll
            for (int kt = 0; kt < 24; ++kt) { f32x4 a = (f32x4){0.f, 0.f, 0.f, 0.f};
                a = MFMA16(ldfrag(sK, kt * 16 + r16, KSB, 8 * q4), bq0, a); a = MFMA16(ldfrag(sK, kt * 16 + r16, KSB, 32 + 8 * q4), bq1, a); sc[kt] = a; if ((kt & 3) == 3) __builtin_amdgcn_sched_barrier(0); }
            float mx = -INFINITY;
            const int relb = 4 * q4 - 128 - qi, kposb = n * 128 - 128 + 4 * q4;
            const LAS float* bl = sBias + r * 260 + relb + 128;
#pragma unroll
            for (int kt = 0; kt < 24; ++kt)
#pragma unroll
                for (int e = 0; e < 4; ++e) { const int rel = relb + kt * 16 + e, kpos = kposb + kt * 16 + e;
                    const bool valid = ((unsigned)(rel + 128) <= 256u) && ((unsigned)kpos < (unsigned)S);
                    const float s = valid ? sc[kt][e] * 0.125f + bl[kt * 16 + e] : -INFINITY;
                    sc[kt][e] = s; mx = fmaxf(mx, s); }
            mx = fmaxf(mx, __shfl_xor(mx, 16)); mx = fmaxf(mx, __shfl_xor(mx, 32)); mx = fmaxf(mx, snk);
            float sum = 0.f;
#pragma unroll
            for (int kt = 0; kt < 24; ++kt)
#pragma unroll
                for (int e = 0; e < 4; ++e) { const float p = __expf(sc[kt][e] - mx); sc[kt][e] = p; sum += p; }
            sum += __shfl_xor(sum, 16); sum += __shfl_xor(sum, 32);
            const float inv = 1.f / (sum + __expf(snk - mx));
            f32x4 o[4];
#pragma unroll
            for (int dt = 0; dt < 4; ++dt) o[dt] = (f32x4){0.f, 0.f, 0.f, 0.f};
#pragma unroll
            for (int kk = 0; kk < 12; ++kk) {
                u32x4 pb; pb.x = pk2(sc[2 * kk][0], sc[2 * kk][1]); pb.y = pk2(sc[2 * kk][2], sc[2 * kk][3]); pb.z = pk2(sc[2 * kk + 1][0], sc[2 * kk + 1][1]); pb.w = pk2(sc[2 * kk + 1][2], sc[2 * kk + 1][3]);
                const bf16x8 bp = __builtin_bit_cast(bf16x8, pb);
#pragma unroll
                for (int dt = 0; dt < 4; ++dt) {
                    lptr vp = sVT + (16 * dt + r16) * VSB + (32 * kk + 4 * q4) * 2;
                    const u32x2 lo = *(const LAS u32x2*)vp, hi = *(const LAS u32x2*)(vp + 32);
                    const u32x4 av = (u32x4){lo.x, lo.y, hi.x, hi.y};
                    o[dt] = MFMA16(__builtin_bit_cast(bf16x8, av), bp, o[dt]);
                }
                __builtin_amdgcn_sched_barrier(0);
            }
            bf16* op = mix + (size_t)(row_q0 + qi) * MIXK + h * 64 + 4 * q4;
#pragma unroll
            for (int dt = 0; dt < 4; ++dt) { u32x2 ov; ov.x = pk2(o[dt][0] * inv, o[dt][1] * inv); ov.y = pk2(o[dt][2] * inv, o[dt][3] * inv); *(u32x2*)(op + 16 * dt) = ov; }
        }
    }
}

__device__ __forceinline__ void p_conv(const bf16* __restrict__ proj, bf16* xact, float* dtv, const float* __restrict__ cw, const float* __restrict__ cb, const float* __restrict__ dtb, int S) {
    const int gt = blockIdx.x * 512 + tid_opaque(), NT = gridDim.x * 512;
    for (int i = gt; i < MS * 160; i += NT) {
        const int row = i / 160, c8 = (i % 160) * 8, t = row % S;
        float acc[8];
#pragma unroll
        for (int e = 0; e < 8; ++e) acc[e] = cb[c8 + e];
#pragma unroll
        for (int k = 0; k < 5; ++k) { const int tt = t + k - 2;
            if (tt >= 0 && tt < S) { float xv[8]; unpack8(*(const u32x4*)(proj + (size_t)(row + k - 2) * EV_N + 1792 + c8), xv);
#pragma unroll
                for (int e = 0; e < 8; ++e) acc[e] += xv[e] * cw[k * 1280 + c8 + e]; } }
        u32x4 o; o.x = pk2(silu_f(acc[0]), silu_f(acc[1])); o.y = pk2(silu_f(acc[2]), silu_f(acc[3])); o.z = pk2(silu_f(acc[4]), silu_f(acc[5])); o.w = pk2(silu_f(acc[6]), silu_f(acc[7]));
        *(u32x4*)(xact + (size_t)row * 1280 + c8) = o;
    }
    for (int i = gt; i < MS * 32; i += NT) { const int row = i >> 5, c = i & 31;
        const float x = bf2f(proj[(size_t)row * EV_N + 3072 + c]) + dtb[c];
        dtv[i] = x > 20.f ? x : log1pf(__expf(x)); }
}

template <bool FINAL>
__device__ __forceinline__ void ssd_scan(lptr lds, const bf16* __restrict__ xact, const float* __restrict__ dtv, const float* __restrict__ a_log, float* ST, float* DEC, bf16* yF, bf16* yB) {
    const int tid = tid_opaque(), lane = tid & 63, w = tid >> 6, r16 = lane & 15, q4 = lane >> 4;
    constexpr int SB = 144;
    lptr sC = lds, sB = lds + 9216, sBT = lds + 18432, sXT = lds + 27648, sXwT = lds + 36864, sW = lds + 46080, sH = lds + 55296;
    LAS float* sdt = (LAS float*)(lds + 64512); LAS float* scs = sdt + 64;
    const int ti = w >> 1, tj0 = 2 * (w & 1);
    const int l_ld = tid >> 3, part = tid & 7;
    for (int u = blockIdx.x; u < 1024; u += gridDim.x) {
        const int dir = u & 1, h = (u >> 1) & 15, seg = u >> 5, g = h >> 3;
        const float a = -__expf(a_log[dir * 16 + h]);
        const int row_seg0 = seg * 512;
        bf16* ydir = dir ? yB : yF;
        f32x4 hacc[2];
#pragma unroll
        for (int jj = 0; jj < 2; ++jj) {
            if (FINAL) { const int p = 16 * (tj0 + jj) + r16, n0 = 16 * ti + 4 * q4; const float* sp = ST + (size_t)u * 4096 + n0 * 64 + p;
                hacc[jj] = (f32x4){sp[0], sp[64], sp[128], sp[192]};
                u32x2 hv; hv.x = pk2(hacc[jj][0], hacc[jj][1]); hv.y = pk2(hacc[jj][2], hacc[jj][3]); *(LAS u32x2*)(sH + p * SB + n0 * 2) = hv;
            } else hacc[jj] = (f32x4){0.f, 0.f, 0.f, 0.f};
        }
        float cs_tot = 0.f;
        for (int ci = 0; ci < 8; ++ci) {
            const int c = dir ? 7 - ci : ci, row_c0 = row_seg0 + c * 64;
            if (w == 0) { const int row = dir ? row_c0 + 63 - lane : row_c0 + lane; const float dt = dtv[row * 32 + dir * 16 + h]; float x = dt * a;
#pragma unroll
                for (int o = 1; o < 64; o <<= 1) { const float y = __shfl_up(x, o); if (lane >= o) x += y; }
                sdt[lane] = dt; scs[lane] = x; }
            const int row_l = dir ? row_c0 + 63 - l_ld : row_c0 + l_ld;
            const bf16* xr = xact + (size_t)row_l * 1280;
            const u32x4 xv = *(const u32x4*)(xr + h * 64 + 8 * part), bv = *(const u32x4*)(xr + 1024 + g * 64 + 8 * part);
            *(LAS u32x4*)(sB + l_ld * SB + part * 16) = bv;
            if (FINAL) { const u32x4 cv = *(const u32x4*)(xr + 1152 + g * 64 + 8 * part); *(LAS u32x4*)(sC + l_ld * SB + part * 16) = cv; }
            { LAS bf16* bt = (LAS bf16*)(sBT + (8 * part) * SB) + l_ld; constexpr int RS = SB / 2;
              bt[0] = (bf16)(bv.x & 0xffffu); bt[RS] = (bf16)(bv.x >> 16); bt[2 * RS] = (bf16)(bv.y & 0xffffu); bt[3 * RS] = (bf16)(bv.y >> 16);
              bt[4 * RS] = (bf16)(bv.z & 0xffffu); bt[5 * RS] = (bf16)(bv.z >> 16); bt[6 * RS] = (bf16)(bv.w & 0xffffu); bt[7 * RS] = (bf16)(bv.w >> 16); }
            if (FINAL) { LAS bf16* xt = (LAS bf16*)(sXT + (8 * part) * SB) + l_ld; constexpr int RS = SB / 2;
              xt[0] = (bf16)(xv.x & 0xffffu); xt[RS] = (bf16)(xv.x >> 16); xt[2 * RS] = (bf16)(xv.y & 0xffffu); xt[3 * RS] = (bf16)(xv.y >> 16);
              xt[4 * RS] = (bf16)(xv.z & 0xffffu); xt[5 * RS] = (bf16)(xv.z >> 16); xt[6 * RS] = (bf16)(xv.w & 0xffffu); xt[7 * RS] = (bf16)(xv.w >> 16); }
            __syncthreads();
            const float cs_last = scs[63];
            { const float wl = __expf(cs_last - scs[l_ld]) * sdt[l_ld]; float xf[8]; unpack8(xv, xf);
              LAS bf16* xt = (LAS bf16*)(sXwT + (8 * part) * SB) + l_ld; constexpr int RS = SB / 2;
#pragma unroll
              for (int e = 0; e < 8; ++e) xt[e * RS] = (bf16)f2bf(xf[e] * wl); }
            __syncthreads();
            if (FINAL) {
                f32x4 yo[2];
#pragma unroll
                for (int jj = 0; jj < 2; ++jj) { const int j = tj0 + jj;
                    f32x4 acc = (f32x4){0.f, 0.f, 0.f, 0.f};
                    if (j <= ti) {
#pragma unroll
                        for (int ks = 0; ks < 2; ++ks) acc = MFMA16(ldfrag(sC, 16 * ti + r16, SB, 32 * ks + 8 * q4), ldfrag(sB, 16 * j + r16, SB, 32 * ks + 8 * q4), acc);
                    }
                    const int s = 16 * j + r16; const float css = scs[s], dts = sdt[s];
#pragma unroll
                    for (int e = 0; e < 4; ++e) { const int l = 16 * ti + 4 * q4 + e; const float v = (s <= l) ? acc[e] * __expf(scs[l] - css) * dts : 0.f;
                        *((LAS bf16*)(sW + l * SB) + s) = (bf16)f2bf(v); }
                    f32x4 y2 = (f32x4){0.f, 0.f, 0.f, 0.f};
#pragma unroll
                    for (int ks = 0; ks < 2; ++ks) y2 = MFMA16(ldfrag(sC, 16 * ti + r16, SB, 32 * ks + 8 * q4), ldfrag(sH, 16 * j + r16, SB, 32 * ks + 8 * q4), y2);
                    yo[jj] = y2;
                }
                __syncthreads();
#pragma unroll
                for (int jj = 0; jj < 2; ++jj) { const int j = tj0 + jj;
                    f32x4 acc = (f32x4){0.f, 0.f, 0.f, 0.f};
#pragma unroll
                    for (int ks = 0; ks < 2; ++ks) acc = MFMA16(ldfrag(sW, 16 * ti + r16, SB, 32 * ks + 8 * q4), ldfrag(sXT, 16 * j + r16, SB, 32 * ks + 8 * q4), acc);
#pragma unroll
                    for (int e = 0; e < 4; ++e) { const int l = 16 * ti + 4 * q4 + e; const float y = acc[e] + __expf(scs[l]) * yo[jj][e];
                        const int row = dir ? row_c0 + 63 - l : row_c0 + l; ydir[(size_t)row * D + h * 64 + 16 * j + r16] = (bf16)f2bf(y); }
                }
            }
            const float dcay = __expf(cs_last);
#pragma unroll
            for (int jj = 0; jj < 2; ++jj) { hacc[jj] = hacc[jj] * dcay;
#pragma unroll
                for (int ks = 0; ks < 2; ++ks) hacc[jj] = MFMA16(ldfrag(sBT, 16 * ti + r16, SB, 32 * ks + 8 * q4), ldfrag(sXwT, 16 * (tj0 + jj) + r16, SB, 32 * ks + 8 * q4), hacc[jj]);
                if (FINAL) { const int p = 16 * (tj0 + jj) + r16, n0 = 16 * ti + 4 * q4;
                    u32x2 hv; hv.x = pk2(hacc[jj][0], hacc[jj][1]); hv.y = pk2(hacc[jj][2], hacc[jj][3]); *(LAS u32x2*)(sH + p * SB + n0 * 2) = hv; }
            }
            cs_tot += cs_last;
            __syncthreads();
        }
        if (!FINAL) {
#pragma unroll
            for (int jj = 0; jj < 2; ++jj) { const int p = 16 * (tj0 + jj) + r16, n0 = 16 * ti + 4 * q4; float* sp = ST + (size_t)u * 4096 + n0 * 64 + p;
                sp[0] = hacc[jj][0]; sp[64] = hacc[jj][1]; sp[128] = hacc[jj][2]; sp[192] = hacc[jj][3]; }
            if (tid == 0) DEC[u] = __expf(cs_tot);
        }
    }
}
__device__ __forceinline__ void ssd_passB(float* ST, const float* __restrict__ DEC, int nseq, int nseg) {
    const int gt = blockIdx.x * 512 + tid_opaque(), NT = gridDim.x * 512;
    const int total = nseq * 32 * 4096;
    for (int e = gt; e < total; e += NT) {
        const int el = e & 4095, chain = e >> 12, hd = chain & 31, seq = chain >> 5, h = hd >> 1, dir = hd & 1;
        float run = 0.f;
        for (int i = 0; i < nseg; ++i) { const int sl = dir ? nseg - 1 - i : i, u = ((seq * nseg + sl) * 16 + h) * 2 + dir;
            float* sp = ST + (size_t)u * 4096 + el; const float t = *sp; *sp = run; run = DEC[u] * run + t; }
    }
}
__device__ __forceinline__ void ssd_post(const bf16* __restrict__ proj, const bf16* __restrict__ xact, const bf16* __restrict__ yF, const bf16* __restrict__ yB, bf16* mix, const float* __restrict__ dsk, const float* __restrict__ nw) {
    const int tid = tid_opaque(), lane = tid & 63, wave = tid >> 6;
    const int gw = blockIdx.x * 8 + wave, NGW = gridDim.x * 8;
    for (int it = gw; it < MS * 2; it += NGW) {
        const int row = it >> 1, grp = it & 1, c = grp * 512 + lane * 8;
        float a[8], b[8], x[8], z[8], y[8];
        unpack8(*(const u32x4*)(yF + (size_t)row * D + c), a); unpack8(*(const u32x4*)(yB + (size_t)row * D + c), b);
        unpack8(*(const u32x4*)(xact + (size_t)row * 1280 + c), x); unpack8(*(const u32x4*)(proj + (size_t)row * EV_N + 768 + c), z);
        const float dd = dsk[c >> 6]; float ss = 0.f;
#pragma unroll
        for (int e = 0; e < 8; ++e) { y[e] = (a[e] + b[e] + dd * x[e]) * silu_f(z[e]); ss += y[e] * y[e]; }
        const float rs = rsqrtf(wave_sum(ss) * (1.f / 512.f) + EPS);
        const f32x4 w0 = *(const f32x4*)(nw + c), w1 = *(const f32x4*)(nw + c + 4);
        u32x4 o; o.x = pk2(y[0] * rs * w0.x, y[1] * rs * w0.y); o.y = pk2(y[2] * rs * w0.z, y[3] * rs * w0.w); o.z = pk2(y[4] * rs * w1.x, y[5] * rs * w1.y); o.w = pk2(y[6] * rs * w1.z, y[7] * rs * w1.w);
        *(u32x4*)(mix + (size_t)row * MIXK + 512 + c) = o;
    }
}

template <bool FINAL>
__device__ __forceinline__ void hg_scan(lptr lds, const bf16* __restrict__ proj, const float* __restrict__ lbraw, int j, float* ST, float* DEC, bf16* oF, bf16* oB) {
    const int tid = tid_opaque(), lane = tid & 63, w = tid >> 6, r16 = lane & 15, q4 = lane >> 4;
    constexpr int SQB = 272, STB = 80;
    lptr sQ = lds, sKn = lds + 8704, sKsT = lds + 17408, sVT = lds + 27648, sAtt = lds + 37888, sSt = lds + 40448;
    LAS float* sdc = (LAS float*)(lds + 75264); LAS float* spart = (LAS float*)(lds + 75776);
    const int k = tid & 127, part = tid >> 7;
    for (int u = blockIdx.x; u < 512; u += gridDim.x) {
        const int dir = u & 1, h = (u >> 1) & 7, seg = u >> 4;
        const float lb = (j == 0) ? 0.f : 1.f / (1.f + __expf(lbraw[h * 128 + k] - lbraw[1024 + h * 128 + k]));
        const int row_seg0 = seg * 512;
        bf16* odir = dir ? oB : oF;
        f32x4 sacc[8];
#pragma unroll
        for (int vt = 0; vt < 8; ++vt) {
            if (FINAL) { const int v = 16 * vt + r16, k0 = 16 * w + 4 * q4; const float* sp = ST + (size_t)u * 16384 + k0 * 128 + v;
                sacc[vt] = (f32x4){sp[0], sp[128], sp[256], sp[384]};
                u32x2 hv; hv.x = pk2(sacc[vt][0], sacc[vt][1]); hv.y = pk2(sacc[vt][2], sacc[vt][3]); *(LAS u32x2*)(sSt + v * SQB + k0 * 2) = hv;
            } else sacc[vt] = (f32x4){0.f, 0.f, 0.f, 0.f};
        }
        float gtot = 0.f;
        for (int ci = 0; ci < 16; ++ci) {
            const int c = dir ? 15 - ci : ci, row_c0 = row_seg0 + c * 32;
            float qv[8], kk[8], G[8]; float run = 0.f; unsigned vp[4];
#pragma unroll
            for (int i = 0; i < 8; ++i) { const int l = 8 * part + i, row = dir ? row_c0 + 31 - l : row_c0 + l;
                const bf16* pr = proj + (size_t)row * OD_N + h * 128 + k;
                const float fr = bf2f(pr[1024 + dir * 1024]);
                if (FINAL) qv[i] = silu_f(bf2f(pr[0]));
                const unsigned vb = pr[3072];
                if (i & 1) vp[i >> 1] |= vb << 16; else vp[i >> 1] = vb;
                const float sig = 1.f / (1.f + __expf(-fr)); const float f = lb + (1.f - lb) * sig;
                kk[i] = (1.f - lb) * (1.f - sig); run += __logf(fmaxf(f, 1e-30f)); G[i] = run; }
            spart[part * 128 + k] = run;
            *(LAS u32x4*)(sVT + k * STB + part * 16) = (u32x4){vp[0], vp[1], vp[2], vp[3]};
            __syncthreads();
            float prefix = 0.f, total = 0.f;
#pragma unroll
            for (int pp = 0; pp < 4; ++pp) { const float t = spart[pp * 128 + k]; total += t; if (pp < part) prefix += t; }
            float ks8[8];
#pragma unroll
            for (int i = 0; i < 8; ++i) { const float Gi = prefix + G[i]; const int l = 8 * part + i;
                if (FINAL) { *((LAS bf16*)(sQ + l * SQB) + k) = (bf16)f2bf(qv[i] * __expf(Gi)); *((LAS bf16*)(sKn + l * SQB) + k) = (bf16)f2bf(kk[i] * __expf(fminf(-Gi, 80.f))); }
                ks8[i] = kk[i] * __expf(total - Gi); }
            *(LAS u32x4*)(sKsT + k * STB + part * 16) = (u32x4){pk2(ks8[0], ks8[1]), pk2(ks8[2], ks8[3]), pk2(ks8[4], ks8[5]), pk2(ks8[6], ks8[7])};
            if (part == 0) { sdc[k] = __expf(total); gtot += total; }
            __syncthreads();
            f32x4 oacc[2];
            if (FINAL) {
                if (w < 4) { const int i = w >> 1, jt = w & 1; f32x4 acc = (f32x4){0.f, 0.f, 0.f, 0.f};
                    if (jt <= i) {
#pragma unroll
                        for (int ks = 0; ks < 4; ++ks) acc = MFMA16(ldfrag(sQ, 16 * i + r16, SQB, 32 * ks + 8 * q4), ldfrag(sKn, 16 * jt + r16, SQB, 32 * ks + 8 * q4), acc);
                    }
                    const int s = 16 * jt + r16;
#pragma unroll
                    for (int e = 0; e < 4; ++e) { const int l = 16 * i + 4 * q4 + e; *((LAS bf16*)(sAtt + l * STB) + s) = (bf16)f2bf((s <= l) ? acc[e] : 0.f); }
                }
#pragma unroll
                for (int lt = 0; lt < 2; ++lt) { f32x4 acc = (f32x4){0.f, 0.f, 0.f, 0.f};
#pragma unroll
                    for (int ks = 0; ks < 4; ++ks) acc = MFMA16(ldfrag(sQ, 16 * lt + r16, SQB, 32 * ks + 8 * q4), ldfrag(sSt, 16 * w + r16, SQB, 32 * ks + 8 * q4), acc);
                    oacc[lt] = acc; }
                __syncthreads();
#pragma unroll
                for (int lt = 0; lt < 2; ++lt) { oacc[lt] = MFMA16(ldfrag(sAtt, 16 * lt + r16, STB, 8 * q4), ldfrag(sVT, 16 * w + r16, STB, 8 * q4), oacc[lt]);
#pragma unroll
                    for (int e = 0; e < 4; ++e) { const int l = 16 * lt + 4 * q4 + e, row = dir ? row_c0 + 31 - l : row_c0 + l;
                        odir[(size_t)row * D + h * 128 + 16 * w + r16] = (bf16)f2bf(oacc[lt][e]); } }
            }
            { const bf16x8 af = ldfrag(sKsT, 16 * w + r16, STB, 8 * q4);
              const f32x4 dcv = *(const LAS f32x4*)(sdc + 16 * w + 4 * q4);
#pragma unroll
              for (int vt = 0; vt < 8; ++vt) { sacc[vt] = sacc[vt] * dcv; sacc[vt] = MFMA16(af, ldfrag(sVT, 16 * vt + r16, STB, 8 * q4), sacc[vt]);
                  if (FINAL) { const int v = 16 * vt + r16, k0 = 16 * w + 4 * q4;
                      u32x2 hv; hv.x = pk2(sacc[vt][0], sacc[vt][1]); hv.y = pk2(sacc[vt][2], sacc[vt][3]); *(LAS u32x2*)(sSt + v * SQB + k0 * 2) = hv; } } }
            __syncthreads();
        }
        if (!FINAL) {
#pragma unroll
            for (int vt = 0; vt < 8; ++vt) { const int v = 16 * vt + r16, k0 = 16 * w + 4 * q4; float* sp = ST + (size_t)u * 16384 + k0 * 128 + v;
                sp[0] = sacc[vt][0]; sp[128] = sacc[vt][1]; sp[256] = sacc[vt][2]; sp[384] = sacc[vt][3]; }
            if (part == 0) DEC[u * 128 + k] = __expf(gtot);
        }
    }
}
__device__ __forceinline__ void hg_passB(float* ST, const float* __restrict__ DEC, int nseq, int nseg) {
    const int gt = blockIdx.x * 512 + tid_opaque(), NT = gridDim.x * 512;
    const int total = nseq * 16 * 16384;
    for (int e = gt; e < total; e += NT) {
        const int el = e & 16383, chain = e >> 14, hd = chain & 15, seq = chain >> 4, h = hd >> 1, dir = hd & 1;
        float run = 0.f;
        for (int i = 0; i < nseg; ++i) { const int sl = dir ? nseg - 1 - i : i, u = ((seq * nseg + sl) * 8 + h) * 2 + dir;
            float* sp = ST + (size_t)u * 16384 + el; const float t = *sp; *sp = run; run = DEC[u * 128 + (el >> 7)] * run + t; }
    }
}
__device__ __forceinline__ void hg_post(const bf16* __restrict__ proj, const bf16* __restrict__ oF, const bf16* __restrict__ oB, bf16* mix, const float* __restrict__ nw) {
    const int tid = tid_opaque(), lane = tid & 63, wave = tid >> 6;
    const int gw = blockIdx.x * 8 + wave, NGW = gridDim.x * 8;
    for (int row = gw; row < MS; row += NGW) {
        const int c = lane * 16;
        float a[16], b[8], gg[16];
        unpack8(*(const u32x4*)(oF + (size_t)row * D + c), b);
#pragma unroll
        for (int e = 0; e < 8; ++e) a[e] = b[e];
        unpack8(*(const u32x4*)(oF + (size_t)row * D + c + 8), b);
#pragma unroll
        for (int e = 0; e < 8; ++e) a[8 + e] = b[e];
        unpack8(*(const u32x4*)(oB + (size_t)row * D + c), b);
#pragma unroll
        for (int e = 0; e < 8; ++e) a[e] += b[e];
        unpack8(*(const u32x4*)(oB + (size_t)row * D + c + 8), b);
#pragma unroll
        for (int e = 0; e < 8; ++e) a[8 + e] += b[e];
        unpack8(*(const u32x4*)(proj + (size_t)row * OD_N + 4096 + c), b);
#pragma unroll
        for (int e = 0; e < 8; ++e) gg[e] = b[e];
        unpack8(*(const u32x4*)(proj + (size_t)row * OD_N + 4096 + c + 8), b);
#pragma unroll
        for (int e = 0; e < 8; ++e) gg[8 + e] = b[e];
        float ss = 0.f;
#pragma unroll
        for (int e = 0; e < 16; ++e) ss += a[e] * a[e];
        ss += __shfl_xor(ss, 1); ss += __shfl_xor(ss, 2); ss += __shfl_xor(ss, 4);
        const float rs = rsqrtf(ss * (1.f / 128.f) + EPS);
        float o[16];
#pragma unroll
        for (int e = 0; e < 16; ++e) o[e] = a[e] * rs * nw[(c & 127) + e] * silu_f(gg[e]);
        u32x4 o0, o1; o0.x = pk2(o[0], o[1]); o0.y = pk2(o[2], o[3]); o0.z = pk2(o[4], o[5]); o0.w = pk2(o[6], o[7]);
        o1.x = pk2(o[8], o[9]); o1.y = pk2(o[10], o[11]); o1.z = pk2(o[12], o[13]); o1.w = pk2(o[14], o[15]);
        *(u32x4*)(mix + (size_t)row * D + c) = o0; *(u32x4*)(mix + (size_t)row * D + c + 8) = o1;
    }
}

constexpr int PH_PER_SLAB = 1 + 2 * (11 + 10);
constexpr int N_PHASES = 1 + NSLAB * PH_PER_SLAB;

__global__ void __launch_bounds__(512, 2) mega(Params P) {
    extern __shared__ __attribute__((aligned(16))) unsigned char lds_raw[];
    lptr lds = (lptr)lds_raw;
    cg::grid_group grid = cg::this_grid();
    const int lo = P.ph_lo, hi = P.ph_hi; int pc = 0;
#define PH(...) do { if (pc >= lo && pc < hi) { __VA_ARGS__; if (pc + 1 < hi) grid.sync(); } ++pc; } while (0)
    unsigned char* ws = P.ws;
    bf16* HN = (bf16*)(ws + WS_HN); bf16* PROJ = (bf16*)(ws + WS_PROJ); bf16* XACT = (bf16*)(ws + WS_XACT); bf16* MIX = (bf16*)(ws + WS_MIX);
    float* MB = (float*)(ws + WS_M); bf16* YF = (bf16*)(ws + WS_M); bf16* YB = (bf16*)(ws + WS_M + 32 * MiB);
    float* ST = (float*)(ws + WS_ST); float* DEC = (float*)(ws + WS_DEC); float* DTV = (float*)(ws + WS_DT);
    const float* NG = P.in[2];

    PH(p0_weights(P, lds));
#pragma unroll 1
    for (int slab = 0; slab < NSLAB; ++slab) {
        const float* xin = (slab < 2) ? P.in[0] + (size_t)slab * MS * D : P.in[1];
        float* X = P.out + (size_t)slab * MS * D;
        const int S = (slab < 2) ? 2048 : 16384, nseq = MS / S, nseg = S / 512;
        PH(p_init(xin, X, HN, NG));
#pragma unroll 1
        for (int l = 0; l < DEPTH; ++l) {
            const int j = l >> 1; const float* g = NG + (size_t)l * 4 * D;
            if ((l & 1) == 0) {
                PH({ pg8::Gemm gm{HN, (const bf16*)(ws + WS_EVIN + j * SZ_EVIN), MS, EV_N, D}; pg8::StaticOrder so; so.init(MS, EV_N, gridDim.x, blockIdx.x);
                     pg8::EpiBf16 ep{PROJ, EV_N}; pg8::gemm_phase<pg8::EpiBf16, pg8::StaticOrder, true, true>(lds, gm, so, ep); });
                PH({ p_attn(lds, PROJ, MIX, P.in[3], P.in[5] + j * 8, S);
                     p_conv(PROJ, XACT, DTV, P.in[6] + (size_t)j * 5 * 1280, P.in[7] + j * 1280, P.in[9] + j * 32, S); });
                PH(ssd_scan<false>(lds, XACT, DTV, P.in[8] + j * 32, ST, DEC, YF, YB));
                PH(ssd_passB(ST, DEC, nseq, nseg));
                PH(ssd_scan<true>(lds, XACT, DTV, P.in[8] + j * 32, ST, DEC, YF, YB));
                PH(ssd_post(PROJ, XACT, YF, YB, MIX, P.in[10] + j * 16, P.in[11] + j * 1024));
                PH({ pg8::Gemm gm{MIX, (const bf16*)(ws + WS_EVOUT + j * SZ_EVOUT), MS, D, MIXK}; pg8::StaticOrder so; so.init(MS, D, gridDim.x, blockIdx.x);
                     pg8::EpiF32 ep{MB, D}; pg8::gemm_phase<pg8::EpiF32, pg8::StaticOrder, true, true>(lds, gm, so, ep); });
            } else {
                PH({ pg8::Gemm gm{HN, (const bf16*)(ws + WS_ODIN + j * SZ_ODIN), MS, OD_N, D}; pg8::StaticOrder so; so.init(MS, OD_N, gridDim.x, blockIdx.x);
                     pg8::EpiBf16 ep{PROJ, OD_N}; pg8::gemm_phase<pg8::EpiBf16, pg8::StaticOrder, true, true>(lds, gm, so, ep); });
                PH(hg_scan<false>(lds, PROJ, P.in[14], j, ST, DEC, YF, YB));
                PH(hg_passB(ST, DEC, nseq, nseg));
                PH(hg_scan<true>(lds, PROJ, P.in[14], j, ST, DEC, YF, YB));
                PH(hg_post(PROJ, YF, YB, MIX, P.in[15] + j * 128));
                PH({ pg8::Gemm gm{MIX, (const bf16*)(ws + WS_ODOUT + j * SZ_ODOUT), MS, D, D}; pg8::StaticOrder so; so.init(MS, D, gridDim.x, blockIdx.x);
                     pg8::EpiF32 ep{MB, D}; pg8::gemm_phase<pg8::EpiF32, pg8::StaticOrder, true, true>(lds, gm, so, ep); });
            }
            PH(p_resnorm(X, MB, HN, g + D, g + 2 * D));
            PH({ pg8::Gemm gm{HN, (const bf16*)(ws + WS_FFGU + l * SZ_FFGU), MS, FF2, D}; pg8::StaticOrder so; so.init(MS, FF2, gridDim.x, blockIdx.x);
                 pg8::EpiSwiGLU ep{PROJ, FF}; pg8::gemm_phase<pg8::EpiSwiGLU, pg8::StaticOrder, true, true>(lds, gm, so, ep); });
            PH({ pg8::Gemm gm{PROJ, (const bf16*)(ws + WS_FFD + l * SZ_FFD), MS, D, FF}; pg8::StaticOrder so; so.init(MS, D, gridDim.x, blockIdx.x);
                 pg8::EpiF32 ep{MB, D}; pg8::gemm_phase<pg8::EpiF32, pg8::StaticOrder, true, true>(lds, gm, so, ep); });
            PH(p_resnorm(X, MB, HN, g + 3 * D, (l + 1 < DEPTH) ? g + 4 * D : nullptr));
        }
    }
#undef PH
}

#ifndef N_LAUNCH_MODE
#define N_LAUNCH_MODE 1
#endif
extern "C" void kernel_launch(void* const* d_in, const int* in_sizes, int n_in, void* d_out, int out_size, void* d_ws, size_t ws_size, hipStream_t stream) {
    static int grid = 0;
    if (grid == 0) {
        if (n_in != 20 || ws_size < WS_END) { fprintf(stderr, "kernel_launch: unexpected n_in %d / ws %zu\n", n_in, ws_size); grid = -1; return; }
        int dev = 0, cus = 0, per_cu = 0;
        hipGetDevice(&dev); hipDeviceGetAttribute(&cus, hipDeviceAttributeMultiprocessorCount, dev);
        hipFuncSetAttribute((const void*)mega, hipFuncAttributeMaxDynamicSharedMemorySize, LDS_BYTES);
        hipOccupancyMaxActiveBlocksPerMultiprocessor(&per_cu, (const void*)mega, 512, LDS_BYTES);
        (void)hipGetLastError();
        if (per_cu < 1) per_cu = 1;
        grid = cus * 1;
        if (grid > 256) grid = 256;
    }
    if (grid < 0) return;
    Params p{};
    for (int i = 0; i < 20; ++i) p.in[i] = (const float*)d_in[i];
    p.out = (float*)d_out; p.ws = (unsigned char*)d_ws;
#if N_LAUNCH_MODE == 1
    p.ph_lo = 0; p.ph_hi = N_PHASES;
    void* args[] = {&p};
    hipError_t e = hipLaunchCooperativeKernel((const void*)mega, dim3(grid), dim3(512), args, LDS_BYTES, stream);
    if (e != hipSuccess) fprintf(stderr, "cooperative launch failed: %s (grid %d)\n", hipGetErrorString(e), grid);
#else
    for (int ph = 0; ph < N_PHASES; ++ph) { p.ph_lo = ph; p.ph_hi = ph + 1; hipLaunchKernelGGL(mega, dim3(grid), dim3(512), LDS_BYTES, stream, p); }
#endif
}
```

```cpp
#include <hip/hip_runtime.h>
#include <hip/hip_cooperative_groups.h>
#include <cstdio>
#include <cstdint>
namespace cg = cooperative_groups;
__device__ __forceinline__ int tid_opaque() { int t = threadIdx.x; asm volatile("" : "+v"(t)); return t; }
namespace pg8 {
#define PG8_LAS __attribute__((address_space(3)))
typedef unsigned short bf16_t;
typedef short bf16x8 __attribute__((ext_vector_type(8)));
typedef float f32x4 __attribute__((ext_vector_type(4)));
typedef unsigned u32x4 __attribute__((ext_vector_type(4)));
constexpr int BM = 256, BK = 64, HALF = 128, HTB = HALF * BK * 2  , STAGE_BYTES = 8 * HTB, NXCD = 8, WGM = 8;

__host__ __device__ __forceinline__ int lds_byte(int r, int c) { const int st = (r >> 4) * 2 + (c >> 5), rr = r & 15, cc = c & 31, ob = rr * 64 + cc * 2; return st * 1024 + (ob ^ (((ob >> 9) & 1) << 5)); }
__host__ __device__ __forceinline__ void stage_rc(int b, int& R, int& C) { const int st = b / 1024, sb = b % 1024, swz = sb ^ (((sb >> 9) & 1) << 5); R = (st >> 1) * 16 + swz / 64; C = (st & 1) * 32 + (swz % 64) / 2; }
__host__ __device__ __forceinline__ int perm32(int rho) { const int n = rho >> 4, i = rho & 15; return 8 * (i >> 2) + 4 * n + (i & 3); }

struct Unit { int pm, pn; };
struct Gemm { const bf16_t* A; const bf16_t* Bt; int M, N, K; };

struct StaticOrder {
    int nM, nN, nwg, G, c;
    __host__ __device__ void init(int M, int N, int G_, int c_) { nM = M / BM; nN = N / BM; nwg = nM * nN; G = G_; c = c_; }
    __host__ __device__ bool next(int i, Unit& u) const {
        const long L = (long)i * G + c; if (L >= nwg) return false;
        int wgid = (int)L; { const int q = nwg / NXCD, r = nwg % NXCD, xcd = wgid % NXCD, off = wgid / NXCD; wgid = (xcd < r ? xcd * (q + 1) : r * (q + 1) + (xcd - r) * q) + off; }
        const int nig = WGM * nN, gid = wgid / nig, fm = gid * WGM, gsz = (nM - fm) < WGM ? (nM - fm) : WGM;
        u.pm = fm + ((wgid % nig) % gsz); u.pn = (wgid % nig) / gsz; return true;
    }
    __device__ __forceinline__ void a_ready(const Unit&) const {}
    __device__ __forceinline__ void done(const Unit&) const {}
};

__device__ __forceinline__ unsigned cvt_pk_bf16(float lo, float hi) { unsigned r; asm volatile("v_cvt_pk_bf16_f32 %0, %1, %2" : "=v"(r) : "v"(lo), "v"(hi)); return r; }
struct EpiBf16 {
    static constexpr bool PERM = true, AFTER_DRAIN = false;
    bf16_t* O; int ldc;
    __device__ __forceinline__ void operator()(const f32x4 (&acc)[2][2][4][2], const Unit& u, int wr, int wc, int fr, int fq) const {
        const int row0 = u.pm * BM + wr * 64 + fr; const int col0 = u.pn * BM + wc * 32 + 8 * fq;
#pragma unroll
        for (int ai = 0; ai < 2; ++ai)
#pragma unroll
            for (int m = 0; m < 4; ++m) { bf16_t* rowp = O + (size_t)(row0 + ai * HALF + m * 16) * ldc + col0;
#pragma unroll
                for (int bj = 0; bj < 2; ++bj) { const f32x4 v0 = acc[ai][bj][m][0], v1 = acc[ai][bj][m][1];
                    u32x4 w; w.x = cvt_pk_bf16(v0[0], v0[1]); w.y = cvt_pk_bf16(v0[2], v0[3]); w.z = cvt_pk_bf16(v1[0], v1[1]); w.w = cvt_pk_bf16(v1[2], v1[3]);
                    *(u32x4*)(rowp + bj * HALF) = w; } }
    }
};
struct EpiF32 {
    static constexpr bool PERM = false, AFTER_DRAIN = false;
    float* O; int ldc;
    __device__ __forceinline__ void operator()(const f32x4 (&acc)[2][2][4][2], const Unit& u, int wr, int wc, int fr, int fq) const {
        const int row0 = u.pm * BM + wr * 64 + fr; const int col0 = u.pn * BM + wc * 32 + 4 * fq;
#pragma unroll
        for (int ai = 0; ai < 2; ++ai)
#pragma unroll
            for (int m = 0; m < 4; ++m) { float* rowp = O + (size_t)(row0 + ai * HALF + m * 16) * ldc + col0;
#pragma unroll
                for (int bj = 0; bj < 2; ++bj)
#pragma unroll
                    for (int n = 0; n < 2; ++n) *(f32x4*)(rowp + bj * HALF + 16 * n) = acc[ai][bj][m][n]; }
    }
};
struct EpiSwiGLU {
    static constexpr bool PERM = true, AFTER_DRAIN = false;
    bf16_t* O; int ldc;
    __device__ __forceinline__ void operator()(const f32x4 (&acc)[2][2][4][2], const Unit& u, int wr, int wc, int fr, int fq) const {
        const int row0 = u.pm * BM + wr * 64 + fr; const int col0 = u.pn * HALF + wc * 32 + 8 * fq;
#pragma unroll
        for (int ai = 0; ai < 2; ++ai)
#pragma unroll
            for (int m = 0; m < 4; ++m) { bf16_t* rowp = O + (size_t)(row0 + ai * HALF + m * 16) * ldc + col0;
                float r[8];
#pragma unroll
                for (int n = 0; n < 2; ++n)
#pragma unroll
                    for (int e = 0; e < 4; ++e) { const float g = acc[ai][0][m][n][e], up = acc[ai][1][m][n][e]; r[n * 4 + e] = g / (1.f + __expf(-g)) * up; }
                u32x4 w; w.x = cvt_pk_bf16(r[0], r[1]); w.y = cvt_pk_bf16(r[2], r[3]); w.z = cvt_pk_bf16(r[4], r[5]); w.w = cvt_pk_bf16(r[6], r[7]);
                *(u32x4*)rowp = w; }
    }
};

template <class Epi, class Sched, bool ALIGN_EPI = false, bool SP2 = false>
__device__ __forceinline__ void gemm_phase(PG8_LAS unsigned char* lds, const Gemm g, const Sched& S, const Epi& E) {
    const int tid = tid_opaque(), wid = __builtin_amdgcn_readfirstlane(tid >> 6), lane = tid & 63, wr = wid >> 2, wc = wid & 3, fr = lane & 15, fq = lane >> 4;
    const int K = g.K, nt = K / BK;
    unsigned voffA[2], voffB[2];
#pragma unroll
    for (int i = 0; i < 2; ++i) { int R, C; stage_rc(tid * 16 + i * 8192, R, C); const int Rb = Epi::PERM ? ((R & ~31) + perm32(R & 31)) : R;
        voffA[i] = (unsigned)(R * K + C) * 2u; voffB[i] = (unsigned)(Rb * K + C) * 2u; }
    const size_t kstep = (size_t)(BK * 2);
    const size_t hstep = (size_t)HALF * K * 2;
    const size_t tstep = 2 * hstep;
    const unsigned ldsw = (unsigned)wid * 1024u;
    const int aoff = lds_byte(wr * 64 + fr, fq * 8), boff = lds_byte(wc * 32 + fr, fq * 8);
#define PG8_SA(b, h) (((b) * 2 + (h)) * HTB)
#define PG8_SB(b, h) ((4 + (b) * 2 + (h)) * HTB)
#define PG8_STAGE(bufoff, gbase, voff) do { _Pragma("unroll") for (int _i = 0; _i < 2; ++_i) \
        __builtin_amdgcn_global_load_lds((const unsigned*)((const char*)(gbase) + (voff)[_i]), (PG8_LAS unsigned*)(lds + (bufoff) + ldsw + _i * 8192), 16, 0, 0); } while (0)
#define PG8_LDA(dst, b, h) do { _Pragma("unroll") for (int m = 0; m < 4; ++m) _Pragma("unroll") for (int k = 0; k < 2; ++k) dst[m][k] = *(const PG8_LAS bf16x8*)(lds + PG8_SA(b, h) + aoff + m * 2048 + k * 1024); } while (0)
#define PG8_LDB(dst, b, h) do { _Pragma("unroll") for (int n = 0; n < 2; ++n) _Pragma("unroll") for (int k = 0; k < 2; ++k) dst[n][k] = *(const PG8_LAS bf16x8*)(lds + PG8_SB(b, h) + boff + n * 2048 + k * 1024); } while (0)
#define PG8_MMA(ai, bj, At, Bt) do { __builtin_amdgcn_s_setprio(1); _Pragma("unroll") for (int m = 0; m < 4; ++m) _Pragma("unroll") for (int n = 0; n < 2; ++n) _Pragma("unroll") for (int k = 0; k < 2; ++k) \
        acc[ai][bj][m][n] = __builtin_amdgcn_mfma_f32_16x16x32_bf16(Bt[n][k], At[m][k], acc[ai][bj][m][n], 0, 0, 0); __builtin_amdgcn_s_setprio(0); } while (0)
#define PG8_WAIT_V(n) asm volatile("s_waitcnt vmcnt(" #n ")" ::: "memory")
#define PG8_WAIT_L(n) asm volatile("s_waitcnt lgkmcnt(" #n ")" ::: "memory")
#define PG8_BAR __builtin_amdgcn_s_barrier()
#define PG8_SCHED __builtin_amdgcn_sched_barrier(0)
    Unit cur, nxt; int ui = 0;
    if (!S.next(0, cur)) return;
    f32x4 acc[2][2][4][2];
#pragma unroll
    for (int a = 0; a < 2; ++a)
#pragma unroll
        for (int b = 0; b < 2; ++b)
#pragma unroll
            for (int m = 0; m < 4; ++m)
#pragma unroll
                for (int n = 0; n < 2; ++n) acc[a][b][m][n] = (f32x4){0.f, 0.f, 0.f, 0.f};
    bf16x8 At[4][2], B0[2][2], B1[2][2];
    const char* cA = (const char*)g.A + (size_t)cur.pm * tstep; const char* cB = (const char*)g.Bt + (size_t)cur.pn * tstep;
    S.a_ready(cur);
    if constexpr (SP2) {
        PG8_STAGE(PG8_SB(0, 0), cB, voffB); PG8_STAGE(PG8_SB(0, 1), cB + hstep, voffB); PG8_STAGE(PG8_SA(0, 0), cA, voffA); PG8_STAGE(PG8_SA(0, 1), cA + hstep, voffA);
        if (wr == 1) PG8_BAR;
        PG8_WAIT_V(2); PG8_BAR;
        PG8_STAGE(PG8_SB(1, 0), cB + kstep, voffB); PG8_STAGE(PG8_SA(1, 0), cA + kstep, voffA); PG8_STAGE(PG8_SB(1, 1), cB + hstep + kstep, voffB);
        PG8_WAIT_V(6); PG8_BAR;
    } else {
        PG8_STAGE(PG8_SB(0, 0), cB, voffB); PG8_STAGE(PG8_SA(0, 0), cA, voffA); PG8_STAGE(PG8_SB(0, 1), cB + hstep, voffB); PG8_STAGE(PG8_SA(0, 1), cA + hstep, voffA);
        if (wr == 1) PG8_BAR;
        PG8_WAIT_V(4); PG8_BAR;
        PG8_STAGE(PG8_SB(1, 0), cB + kstep, voffB); PG8_STAGE(PG8_SA(1, 0), cA + kstep, voffA); PG8_STAGE(PG8_SB(1, 1), cB + hstep + kstep, voffB);
        PG8_WAIT_V(6); PG8_BAR;
    }
    for (;;) {
        const bool has_next = S.next(ui + 1, nxt);
        const char* nA = has_next ? (const char*)g.A + (size_t)nxt.pm * tstep : cA; const char* nB = has_next ? (const char*)g.Bt + (size_t)nxt.pn * tstep : cB;
        for (int t = 0; t < nt; t += 2) {
            const bool last = (t == nt - 2);
            const char* a1 = cA + (size_t)(t + 1) * kstep;
            const char* a2 = last ? nA : cA + (size_t)(t + 2) * kstep; const char* b2 = last ? nB : cB + (size_t)(t + 2) * kstep;
            const char* a3 = a2 + kstep; const char* b3 = b2 + kstep;
            if (last && has_next) S.a_ready(nxt);
            if constexpr (SP2) {
            PG8_LDB(B0, 0, 0); PG8_LDB(B1, 0, 1); PG8_SCHED; PG8_LDA(At, 0, 0); PG8_STAGE(PG8_SA(1, 1), a1 + hstep, voffA);
            PG8_WAIT_V(8); PG8_WAIT_L(0); PG8_BAR; PG8_MMA(0, 0, At, B0); PG8_MMA(0, 1, At, B1); PG8_BAR; PG8_SCHED;
            PG8_LDA(At, 0, 1); PG8_STAGE(PG8_SB(0, 0), b2, voffB); PG8_STAGE(PG8_SB(0, 1), b2 + hstep, voffB); PG8_STAGE(PG8_SA(0, 0), a2, voffA);
            PG8_WAIT_V(8); PG8_WAIT_L(0); PG8_BAR; PG8_MMA(1, 0, At, B0); PG8_MMA(1, 1, At, B1); PG8_BAR; PG8_SCHED;
            PG8_LDB(B0, 1, 0); PG8_LDB(B1, 1, 1); PG8_SCHED; PG8_LDA(At, 1, 0); PG8_STAGE(PG8_SA(0, 1), a2 + hstep, voffA);
            PG8_WAIT_V(8); PG8_WAIT_L(0); PG8_BAR; PG8_MMA(0, 0, At, B0); PG8_MMA(0, 1, At, B1); PG8_BAR; PG8_SCHED;
            PG8_LDA(At, 1, 1); PG8_STAGE(PG8_SB(1, 0), b3, voffB); PG8_STAGE(PG8_SB(1, 1), b3 + hstep, voffB); PG8_STAGE(PG8_SA(1, 0), a3, voffA);
            PG8_WAIT_V(8); PG8_WAIT_L(0); PG8_BAR; PG8_MMA(1, 0, At, B0); PG8_MMA(1, 1, At, B1); PG8_BAR; PG8_SCHED;
            } else {
            PG8_LDB(B0, 0, 0); PG8_SCHED; PG8_LDA(At, 0, 0); PG8_STAGE(PG8_SA(1, 1), a1 + hstep, voffA);
            PG8_WAIT_L(8); PG8_BAR; PG8_WAIT_L(0); PG8_MMA(0, 0, At, B0); PG8_BAR; PG8_SCHED;
            PG8_LDB(B1, 0, 1); PG8_STAGE(PG8_SB(0, 0), b2, voffB);
            PG8_BAR; PG8_WAIT_L(0); PG8_MMA(0, 1, At, B1); PG8_BAR;
            PG8_LDA(At, 0, 1); PG8_STAGE(PG8_SA(0, 0), a2, voffA);
            PG8_BAR; PG8_WAIT_L(0); PG8_MMA(1, 0, At, B0); PG8_BAR; PG8_SCHED;
            PG8_STAGE(PG8_SB(0, 1), b2 + hstep, voffB);
            PG8_WAIT_V(6); PG8_BAR; PG8_MMA(1, 1, At, B1); PG8_BAR;
            PG8_LDB(B0, 1, 0); PG8_SCHED; PG8_LDA(At, 1, 0); PG8_STAGE(PG8_SA(0, 1), a2 + hstep, voffA);
            PG8_WAIT_L(8); PG8_BAR; PG8_WAIT_L(0); PG8_MMA(0, 0, At, B0); PG8_BAR; PG8_SCHED;
            PG8_LDB(B1, 1, 1); PG8_STAGE(PG8_SB(1, 0), b3, voffB);
            PG8_BAR; PG8_WAIT_L(0); PG8_MMA(0, 1, At, B1); PG8_BAR;
            PG8_LDA(At, 1, 1); PG8_STAGE(PG8_SA(1, 0), a3, voffA);
            PG8_BAR; PG8_WAIT_L(0); PG8_MMA(1, 0, At, B0); PG8_BAR; PG8_SCHED;
            PG8_STAGE(PG8_SB(1, 1), b3 + hstep, voffB);
            PG8_WAIT_V(6); PG8_BAR; PG8_MMA(1, 1, At, B1); PG8_BAR;
            }
        }
        if constexpr (ALIGN_EPI) { if (wr == 0) PG8_BAR; }
        if constexpr (!Epi::AFTER_DRAIN) { E(acc, cur, wr, wc, fr, fq); S.done(cur); }
        if (!has_next) break;
#pragma unroll
        for (int a = 0; a < 2; ++a)
#pragma unroll
            for (int b = 0; b < 2; ++b)
#pragma unroll
                for (int m = 0; m < 4; ++m)
#pragma unroll
                    for (int n = 0; n < 2; ++n) acc[a][b][m][n] = (f32x4){0.f, 0.f, 0.f, 0.f};
        cur = nxt; cA = nA; cB = nB; ++ui;
        if constexpr (ALIGN_EPI) { if (wr == 1) PG8_BAR; }
    }
    PG8_WAIT_V(0);
    if constexpr (!ALIGN_EPI) { if (wr == 0) PG8_BAR; }
    PG8_BAR;
    if constexpr (Epi::AFTER_DRAIN) { E.fused(acc, cur, wr, wc, fr, fq, lds, wid, lane); S.done(cur); }
#undef PG8_SA
#undef PG8_SB
#undef PG8_STAGE
#undef PG8_LDA
#undef PG8_LDB
#undef PG8_MMA
#undef PG8_WAIT_V
#undef PG8_WAIT_L
#undef PG8_BAR
#undef PG8_SCHED
}
}
#define LAS __attribute__((address_space(3)))
typedef unsigned short bf16;
typedef LAS unsigned char* lptr;
typedef short bf16x8 __attribute__((ext_vector_type(8)));
typedef float f32x4 __attribute__((ext_vector_type(4)));
typedef unsigned u32x4 __attribute__((ext_vector_type(4)));
typedef unsigned u32x2 __attribute__((ext_vector_type(2)));

constexpr int D = 1024, MS = 16384, NSLAB = 3, DEPTH = 4;
constexpr int EV_N = 3328, EV_NREAL = 3104, OD_N = 5120, FF = 2816, FF2 = 5632, MIXK = 1536;
constexpr float EPS = 1e-6f;
constexpr size_t MiB = 1u << 20;
constexpr size_t WS_EVIN = 1 * MiB;
constexpr size_t SZ_EVIN = (size_t)EV_N * D * 2;
constexpr size_t WS_EVOUT = WS_EVIN + 2 * SZ_EVIN;
constexpr size_t SZ_EVOUT = (size_t)D * MIXK * 2;
constexpr size_t WS_ODIN = WS_EVOUT + 2 * SZ_EVOUT;
constexpr size_t SZ_ODIN = (size_t)OD_N * D * 2;
constexpr size_t WS_ODOUT = WS_ODIN + 2 * SZ_ODIN;
constexpr size_t SZ_ODOUT = (size_t)D * D * 2;
constexpr size_t WS_FFGU = WS_ODOUT + 2 * SZ_ODOUT;
constexpr size_t SZ_FFGU = (size_t)FF2 * D * 2;
constexpr size_t WS_FFD = WS_FFGU + 4 * SZ_FFGU;
constexpr size_t SZ_FFD = (size_t)D * FF * 2;
constexpr size_t WS_WEND = WS_FFD + 4 * SZ_FFD;
static_assert(WS_WEND <= 112 * MiB, "weights region");
constexpr size_t WS_HN = 112 * MiB;
constexpr size_t WS_PROJ = 144 * MiB;
constexpr size_t WS_XACT = WS_PROJ + 104 * MiB;
constexpr size_t WS_MIX = 304 * MiB;
constexpr size_t WS_M = 352 * MiB;
constexpr size_t WS_ST = 416 * MiB;
constexpr size_t WS_DEC = 450 * MiB;
constexpr size_t WS_DT = 452 * MiB;
constexpr size_t WS_END = 456 * MiB;

constexpr int LDS_BYTES = 147456;

__device__ __forceinline__ unsigned f2bf(float f) { unsigned u = __builtin_bit_cast(unsigned, f); return (u + 0x7fffu + ((u >> 16) & 1u)) >> 16; }
__device__ __forceinline__ unsigned pk2(float lo, float hi) { return f2bf(lo) | (f2bf(hi) << 16); }
__device__ __forceinline__ float bf2f(bf16 b) { return __builtin_bit_cast(float, (unsigned)b << 16); }
__device__ __forceinline__ float bflo(unsigned u) { return __builtin_bit_cast(float, u << 16); }
__device__ __forceinline__ float bfhi(unsigned u) { return __builtin_bit_cast(float, u & 0xffff0000u); }
__device__ __forceinline__ float wave_sum(float v) {
#pragma unroll
    for (int o = 1; o < 64; o <<= 1) v += __shfl_xor(v, o);
    return v;
}
__device__ __forceinline__ float silu_f(float x) { return x / (1.f + __expf(-x)); }
__device__ __forceinline__ bf16x8 ldfrag(lptr base, int row, int strideB, int kelem) { return *(const LAS bf16x8*)(base + row * strideB + kelem * 2); }
__device__ __forceinline__ void unpack8(const u32x4 v, float (&f)[8]) {
    f[0] = bflo(v.x); f[1] = bfhi(v.x); f[2] = bflo(v.y); f[3] = bfhi(v.y); f[4] = bflo(v.z); f[5] = bfhi(v.z); f[6] = bflo(v.w); f[7] = bfhi(v.w);
}
#define MFMA16(a, b, c) __builtin_amdgcn_mfma_f32_16x16x32_bf16((a), (b), (c), 0, 0, 0)
#define LDSWAIT() asm volatile("s_waitcnt lgkmcnt(0)" ::: "memory")

struct Params {
    const float* in[20];
    float* out;
    unsigned char* ws;
    int ph_lo, ph_hi;
};

__device__ __forceinline__ void tr_matrix(const float* __restrict__ W, int K, int N, bf16* WT, int mode, int gw, int NGW, LAS float* scr, int lane) {
    const int nnb = N / 32, items = (K / 64) * nnb;
    for (int it = gw; it < items; it += NGW) {
        const int kb = it / nnb, nb = it % nnb, k0 = 64 * kb, n0 = 32 * nb;
        const int drow0 = (mode == 0) ? n0 : (256 * (n0 >> 7) + (n0 & 127) + (mode == 2 ? 128 : 0));
#pragma unroll 8
        for (int i = 0; i < 32; ++i) { const int kk = 2 * i + (lane >> 5); scr[kk * 33 + (lane & 31)] = W[(size_t)(k0 + kk) * N + n0 + (lane & 31)]; }
        LDSWAIT();
        const int c = lane & 7;
#pragma unroll
        for (int j = 0; j < 4; ++j) { const int n = (lane >> 3) + 8 * j; const LAS float* s = scr + (8 * c) * 33 + n;
            u32x4 o; o.x = pk2(s[0 * 33], s[1 * 33]); o.y = pk2(s[2 * 33], s[3 * 33]); o.z = pk2(s[4 * 33], s[5 * 33]); o.w = pk2(s[6 * 33], s[7 * 33]);
            *(u32x4*)(WT + (size_t)(drow0 + n) * K + k0 + 8 * c) = o; }
        LDSWAIT();
    }
}
__device__ __forceinline__ void p0_weights(const Params& P, lptr lds) {
    const int tid = tid_opaque(), lane = tid & 63, wave = tid >> 6;
    LAS float* scr = (LAS float*)(lds + wave * 16384);
    const int gw = blockIdx.x * 8 + wave, NGW = gridDim.x * 8;
    unsigned char* ws = P.ws;
    for (int j = 0; j < 2; ++j) {
        tr_matrix(P.in[4] + (size_t)j * D * EV_NREAL, D, EV_NREAL, (bf16*)(ws + WS_EVIN + j * SZ_EVIN), 0, gw, NGW, scr, lane);
        tr_matrix(P.in[12] + (size_t)j * MIXK * D, MIXK, D, (bf16*)(ws + WS_EVOUT + j * SZ_EVOUT), 0, gw, NGW, scr, lane);
        tr_matrix(P.in[13] + (size_t)j * D * OD_N, D, OD_N, (bf16*)(ws + WS_ODIN + j * SZ_ODIN), 0, gw, NGW, scr, lane);
        tr_matrix(P.in[16] + (size_t)j * D * D, D, D, (bf16*)(ws + WS_ODOUT + j * SZ_ODOUT), 0, gw, NGW, scr, lane);
    }
    for (int l = 0; l < 4; ++l) {
        tr_matrix(P.in[17] + (size_t)l * D * FF, D, FF, (bf16*)(ws + WS_FFGU + l * SZ_FFGU), 1, gw, NGW, scr, lane);
        tr_matrix(P.in[18] + (size_t)l * D * FF, D, FF, (bf16*)(ws + WS_FFGU + l * SZ_FFGU), 2, gw, NGW, scr, lane);
        tr_matrix(P.in[19] + (size_t)l * FF * D, FF, D, (bf16*)(ws + WS_FFD + l * SZ_FFD), 0, gw, NGW, scr, lane);
    }
    const int gt = blockIdx.x * 512 + tid, NT = gridDim.x * 512;
    for (int i = gt; i < 2 * 224 * 128; i += NT) { const int j = i / (224 * 128), r = i % (224 * 128);
        *(u32x4*)(ws + WS_EVIN + j * SZ_EVIN + (size_t)EV_NREAL * D * 2 + (size_t)r * 16) = (u32x4){0u, 0u, 0u, 0u}; }
}

__device__ __forceinline__ void p_init(const float* __restrict__ xin, float* xo, bf16* hn, const float* __restrict__ g) {
    const int tid = tid_opaque(), lane = tid & 63, wave = tid >> 6;
    const int gw = blockIdx.x * 8 + wave, NGW = gridDim.x * 8;
    for (int r = gw; r < MS; r += NGW) {
        const f32x4* xr = (const f32x4*)(xin + (size_t)r * D) + lane; f32x4 v[4]; float s = 0.f;
#pragma unroll
        for (int j = 0; j < 4; ++j) { v[j] = xr[64 * j]; s += (v[j].x * v[j].x + v[j].y * v[j].y) + (v[j].z * v[j].z + v[j].w * v[j].w); }
        const float rs = rsqrtf(wave_sum(s) * (1.f / D) + EPS);
        f32x4* xw = (f32x4*)(xo + (size_t)r * D) + lane; u32x2* ho = (u32x2*)(hn + (size_t)r * D) + lane; const f32x4* gg = (const f32x4*)g + lane;
#pragma unroll
        for (int j = 0; j < 4; ++j) { xw[64 * j] = v[j]; const f32x4 gv = gg[64 * j];
            u32x2 o; o.x = pk2(v[j].x * rs * gv.x, v[j].y * rs * gv.y); o.y = pk2(v[j].z * rs * gv.z, v[j].w * rs * gv.w); ho[64 * j] = o; }
    }
}
__device__ __forceinline__ void p_resnorm(float* x, const float* __restrict__ m, bf16* hn, const float* __restrict__ gpost, const float* __restrict__ gpre) {
    const int tid = tid_opaque(), lane = tid & 63, wave = tid >> 6;
    const int gw = blockIdx.x * 8 + wave, NGW = gridDim.x * 8;
    for (int r = gw; r < MS; r += NGW) {
        const f32x4* mr = (const f32x4*)(m + (size_t)r * D) + lane; f32x4* xr = (f32x4*)(x + (size_t)r * D) + lane;
        f32x4 mv[4], xv[4]; float s = 0.f;
#pragma unroll
        for (int j = 0; j < 4; ++j) { mv[j] = mr[64 * j]; xv[j] = xr[64 * j]; s += (mv[j].x * mv[j].x + mv[j].y * mv[j].y) + (mv[j].z * mv[j].z + mv[j].w * mv[j].w); }
        const float rs = rsqrtf(wave_sum(s) * (1.f / D) + EPS); float s2 = 0.f;
        const f32x4* gp = (const f32x4*)gpost + lane;
#pragma unroll
        for (int j = 0; j < 4; ++j) { const f32x4 gv = gp[64 * j]; xv[j] = xv[j] + mv[j] * rs * gv; xr[64 * j] = xv[j];
            s2 += (xv[j].x * xv[j].x + xv[j].y * xv[j].y) + (xv[j].z * xv[j].z + xv[j].w * xv[j].w); }
        if (gpre) {
            const float rs2 = rsqrtf(wave_sum(s2) * (1.f / D) + EPS);
            u32x2* ho = (u32x2*)(hn + (size_t)r * D) + lane; const f32x4* gg = (const f32x4*)gpre + lane;
#pragma unroll
            for (int j = 0; j < 4; ++j) { const f32x4 gv = gg[64 * j];
                u32x2 o; o.x = pk2(xv[j].x * rs2 * gv.x, xv[j].y * rs2 * gv.y); o.y = pk2(xv[j].z * rs2 * gv.z, xv[j].w * rs2 * gv.w); ho[64 * j] = o; }
        }
    }
}

__device__ __forceinline__ int t5_bucket(int rel) {
    const int n = rel < 0 ? -rel : rel;
    const int mag = n < 8 ? n : 8 + (n >= 12) + (n >= 16) + (n >= 23) + (n >= 32) + (n >= 46) + (n >= 64) + (n >= 91);
    return (rel > 0 ? 16 : 0) + mag;
}
__device__ __forceinline__ void p_attn(lptr lds, const bf16* __restrict__ proj, bf16* mix, const float* __restrict__ t5, const float* __restrict__ sink, int S) {
    const int tid = tid_opaque(), lane = tid & 63, w = tid >> 6, r16 = lane & 15, q4 = lane >> 4;
    constexpr int KSB = 144, VSB = 784;
    lptr sK = lds, sVT = lds + 55296; LAS float* sBias = (LAS float*)(lds + 105472);
    const int bps = S / 128;
    for (int u = blockIdx.x; u < 256; u += gridDim.x) {
        const int g = u & 1, qb = u >> 1, n = qb % bps, row_q0 = qb * 128;
        __syncthreads();
        for (int i = tid; i < 4 * 257; i += 512) { const int r = i / 257, d = i % 257; sBias[r * 260 + d] = t5[t5_bucket(d - 128) * 8 + 4 * g + r]; }
        for (int c = tid; c < 3072; c += 512) {
            const int key = c >> 3, part = c & 7; const int kpos = n * 128 - 128 + key;
            u32x4 kv = (u32x4){0u, 0u, 0u, 0u}, vv = kv;
            if (kpos >= 0 && kpos < S) { const bf16* pr = proj + (size_t)(row_q0 - 128 + key) * EV_N + g * 64 + 8 * part;
                kv = *(const u32x4*)(pr + 512); vv = *(const u32x4*)(pr + 640); }
            *(LAS u32x4*)(sK + key * KSB + part * 16) = kv;
            LAS bf16* vt = (LAS bf16*)(sVT + (8 * part) * VSB) + key;
            vt[0 * (VSB / 2)] = (bf16)(vv.x & 0xffffu); vt[1 * (VSB / 2)] = (bf16)(vv.x >> 16); vt[2 * (VSB / 2)] = (bf16)(vv.y & 0xffffu); vt[3 * (VSB / 2)] = (bf16)(vv.y >> 16);
            vt[4 * (VSB / 2)] = (bf16)(vv.z & 0xffffu); vt[5 * (VSB / 2)] = (bf16)(vv.z >> 16); vt[6 * (VSB / 2)] = (bf16)(vv.w & 0xffffu); vt[7 * (VSB / 2)] = (bf16)(vv.w >> 16);
        }
        __syncthreads();
        const int r = w >> 1, h = 4 * g + r, qh = w & 1;
        const float snk = sink[h];
        for (int qg = 0; qg < 4; ++qg) {
            const int qi = 64 * qh + 16 * qg + r16;
            const bf16* qp = proj + (size_t)(row_q0 + qi) * EV_N + h * 64 + 8 * q4;
            const bf16x8 bq0 = *(const bf16x8*)qp, bq1 = *(const bf16x8*)(qp + 32);
            f32x4 sc[24];
#pragma unroll
            for (int kt = 0; kt < 24; ++kt) { f32x4 a = (f32x4){0.f, 0.f, 0.f, 0.f};
                a = MFMA16(ldfrag(sK, kt * 16 + r16, KSB, 8 * q4), bq0, a); a = MFMA16(ldfrag(sK, kt * 16 + r16, KSB, 32 + 8 * q4), bq1, a); sc[kt] = a; if ((kt & 3) == 3) __builtin_amdgcn_sched_barrier(0); }
            float mx = -INFINITY;
            const int relb = 4 * q4 - 128 - qi, kposb = n * 128 - 128 + 4 * q4;
            const LAS float* bl = sBias + r * 260 + relb + 128;
#pragma unroll
            for (int kt = 0; kt < 24; ++kt)
#pragma unroll
                for (int e = 0; e < 4; ++e) { const int rel = relb + kt * 16 + e, kpos = kposb + kt * 16 + e;
                    const bool valid = ((unsigned)(rel + 128) <= 256u) && ((unsigned)kpos < (unsigned)S);
                    const float s = valid ? sc[kt][e] * 0.125f + bl[kt * 16 + e] : -INFINITY;
                    sc[kt][e] = s; mx = fmaxf(mx, s); }
            mx = fmaxf(mx, __shfl_xor(mx, 16)); mx = fmaxf(mx, __shfl_xor(mx, 32)); mx = fmaxf(mx, snk);
            float sum = 0.f;
#pragma unroll
            for (int kt = 0; kt < 24; ++kt)
#pragma unroll
                for (int e = 0; e < 4; ++e) { const float p = __expf(sc[kt][e] - mx); sc[kt][e] = p; sum += p; }
            sum += __shfl_xor(sum, 16); sum += __shfl_xor(sum, 32);
            const float inv = 1.f / (sum + __expf(snk - mx));
            f32x4 o[4];
#pragma unroll
            for (int dt = 0; dt < 4; ++dt) o[dt] = (f32x4){0.f, 0.f, 0.f, 0.f};
#pragma unroll
            for (int kk = 0; kk < 12; ++kk) {
                u32x4 pb; pb.x = pk2(sc[2 * kk][0], sc[2 * kk][1]); pb.y = pk2(sc[2 * kk][2], sc[2 * kk][3]); pb.z = pk2(sc[2 * kk + 1][0], sc[2 * kk + 1][1]); pb.w = pk2(sc[2 * kk + 1][2], sc[2 * kk + 1][3]);
                const bf16x8 bp = __builtin_bit_cast(bf16x8, pb);
#pragma unroll
                for (int dt = 0; dt < 4; ++dt) {
                    lptr vp = sVT + (16 * dt + r16) * VSB + (32 * kk + 4 * q4) * 2;
                    const u32x2 lo = *(const LAS u32x2*)vp, hi = *(const LAS u32x2*)(vp + 32);
                    const u32x4 av = (u32x4){lo.x, lo.y, hi.x, hi.y};
                    o[dt] = MFMA16(__builtin_bit_cast(bf16x8, av), bp, o[dt]);
                }
                __builtin_amdgcn_sched_barrier(0);
            }
            bf16* op = mix + (size_t)(row_q0 + qi) * MIXK + h * 64 + 4 * q4;
#pragma unroll
            for (int dt = 0; dt < 4; ++dt) { u32x2 ov; ov.x = pk2(o[dt][0] * inv, o[dt][1] * inv); ov.y = pk2(o[dt][2] * inv, o[dt][3] * inv); *(u32x2*)(op + 16 * dt) = ov; }
        }
    }
}

__device__ __forceinline__ void p_conv(const bf16* __restrict__ proj, bf16* xact, float* dtv, const float* __restrict__ cw, const float* __restrict__ cb, const float* __restrict__ dtb, int S) {
    const int gt = blockIdx.x * 512 + tid_opaque(), NT = gridDim.x * 512;
    for (int i = gt; i < MS * 160; i += NT) {
        const int row = i / 160, c8 = (i % 160) * 8, t = row % S;
        float acc[8];
#pragma unroll
        for (int e = 0; e < 8; ++e) acc[e] = cb[c8 + e];
#pragma unroll
        for (int k = 0; k < 5; ++k) { const int tt = t + k - 2;
            if (tt >= 0 && tt < S) { float xv[8]; unpack8(*(const u32x4*)(proj + (size_t)(row + k - 2) * EV_N + 1792 + c8), xv);
#pragma unroll
                for (int e = 0; e < 8; ++e) acc[e] += xv[e] * cw[k * 1280 + c8 + e]; } }
        u32x4 o; o.x = pk2(silu_f(acc[0]), silu_f(acc[1])); o.y = pk2(silu_f(acc[2]), silu_f(acc[3])); o.z = pk2(silu_f(acc[4]), silu_f(acc[5])); o.w = pk2(silu_f(acc[6]), silu_f(acc[7]));
        *(u32x4*)(xact + (size_t)row * 1280 + c8) = o;
    }
    for (int i = gt; i < MS * 32; i += NT) { const int row = i >> 5, c = i & 31;
        const float x = bf2f(proj[(size_t)row * EV_N + 3072 + c]) + dtb[c];
        dtv[i] = x > 20.f ? x : log1pf(__expf(x)); }
}

template <bool FINAL>
__device__ __forceinline__ void ssd_scan(lptr lds, const bf16* __restrict__ xact, const float* __restrict__ dtv, const float* __restrict__ a_log, float* ST, float* DEC, bf16* yF, bf16* yB) {
    const int tid = tid_opaque(), lane = tid & 63, w = tid >> 6, r16 = lane & 15, q4 = lane >> 4;
    constexpr int SB = 144;
    lptr sC = lds, sB = lds + 9216, sBT = lds + 18432, sXT = lds + 27648, sXwT = lds + 36864, sW = lds + 46080, sH = lds + 55296;
    LAS float* sdt = (LAS float*)(lds + 64512); LAS float* scs = sdt + 64;
    const int ti = w >> 1, tj0 = 2 * (w & 1);
    const int l_ld = tid >> 3, part = tid & 7;
    for (int u = blockIdx.x; u < 1024; u += gridDim.x) {
        const int dir = u & 1, h = (u >> 1) & 15, seg = u >> 5, g = h >> 3;
        const float a = -__expf(a_log[dir * 16 + h]);
        const int row_seg0 = seg * 512;
        bf16* ydir = dir ? yB : yF;
        f32x4 hacc[2];
#pragma unroll
        for (int jj = 0; jj < 2; ++jj) {
            if (FINAL) { const int p = 16 * (tj0 + jj) + r16, n0 = 16 * ti + 4 * q4; const float* sp = ST + (size_t)u * 4096 + n0 * 64 + p;
                hacc[jj] = (f32x4){sp[0], sp[64], sp[128], sp[192]};
                u32x2 hv; hv.x = pk2(hacc[jj][0], hacc[jj][1]); hv.y = pk2(hacc[jj][2], hacc[jj][3]); *(LAS u32x2*)(sH + p * SB + n0 * 2) = hv;
            } else hacc[jj] = (f32x4){0.f, 0.f, 0.f, 0.f};
        }
        float cs_tot = 0.f;
        for (int ci = 0; ci < 8; ++ci) {
            const int c = dir ? 7 - ci : ci, row_c0 = row_seg0 + c * 64;
            if (w == 0) { const int row = dir ? row_c0 + 63 - lane : row_c0 + lane; const float dt = dtv[row * 32 + dir * 16 + h]; float x = dt * a;
#pragma unroll
                for (int o = 1; o < 64; o <<= 1) { const float y = __shfl_up(x, o); if (lane >= o) x += y; }
                sdt[lane] = dt; scs[lane] = x; }
            const int row_l = dir ? row_c0 + 63 - l_ld : row_c0 + l_ld;
            const bf16* xr = xact + (size_t)row_l * 1280;
            const u32x4 xv = *(const u32x4*)(xr + h * 64 + 8 * part), bv = *(const u32x4*)(xr + 1024 + g * 64 + 8 * part);
            *(LAS u32x4*)(sB + l_ld * SB + part * 16) = bv;
            if (FINAL) { const u32x4 cv = *(const u32x4*)(xr + 1152 + g * 64 + 8 * part); *(LAS u32x4*)(sC + l_ld * SB + part * 16) = cv; }
            { LAS bf16* bt = (LAS bf16*)(sBT + (8 * part) * SB) + l_ld; constexpr int RS = SB / 2;
              bt[0] = (bf16)(bv.x & 0xffffu); bt[RS] = (bf16)(bv.x >> 16); bt[2 * RS] = (bf16)(bv.y & 0xffffu); bt[3 * RS] = (bf16)(bv.y >> 16);
              bt[4 * RS] = (bf16)(bv.z & 0xffffu); bt[5 * RS] = (bf16)(bv.z >> 16); bt[6 * RS] = (bf16)(bv.w & 0xffffu); bt[7 * RS] = (bf16)(bv.w >> 16); }
            if (FINAL) { LAS bf16* xt = (LAS bf16*)(sXT + (8 * part) * SB) + l_ld; constexpr int RS = SB / 2;
              xt[0] = (bf16)(xv.x & 0xffffu); xt[RS] = (bf16)(xv.x >> 16); xt[2 * RS] = (bf16)(xv.y & 0xffffu); xt[3 * RS] = (bf16)(xv.y >> 16);
              xt[4 * RS] = (bf16)(xv.z & 0xffffu); xt[5 * RS] = (bf16)(xv.z >> 16); xt[6 * RS] = (bf16)(xv.w & 0xffffu); xt[7 * RS] = (bf16)(xv.w >> 16); }
            __syncthreads();
            const float cs_last = scs[63];
            { const float wl = __expf(cs_last - scs[l_ld]) * sdt[l_ld]; float xf[8]; unpack8(xv, xf);
              LAS bf16* xt = (LAS bf16*)(sXwT + (8 * part) * SB) + l_ld; constexpr int RS = SB / 2;
#pragma unroll
              for (int e = 0; e < 8; ++e) xt[e * RS] = (bf16)f2bf(xf[e] * wl); }
            __syncthreads();
            if (FINAL) {
                f32x4 yo[2];
#pragma unroll
                for (int jj = 0; jj < 2; ++jj) { const int j = tj0 + jj;
                    f32x4 acc = (f32x4){0.f, 0.f, 0.f, 0.f};
                    if (j <= ti) {
#pragma unroll
                        for (int ks = 0; ks < 2; ++ks) acc = MFMA16(ldfrag(sC, 16 * ti + r16, SB, 32 * ks + 8 * q4), ldfrag(sB, 16 * j + r16, SB, 32 * ks + 8 * q4), acc);
                    }
                    const int s = 16 * j + r16; const float css = scs[s], dts = sdt[s];
#pragma unroll
                    for (int e = 0; e < 4; ++e) { const int l = 16 * ti + 4 * q4 + e; const float v = (s <= l) ? acc[e] * __expf(scs[l] - css) * dts : 0.f;
                        *((LAS bf16*)(sW + l * SB) + s) = (bf16)f2bf(v); }
                    f32x4 y2 = (f32x4){0.f, 0.f, 0.f, 0.f};
#pragma unroll
                    for (int ks = 0; ks < 2; ++ks) y2 = MFMA16(ldfrag(sC, 16 * ti + r16, SB, 32 * ks + 8 * q4), ldfrag(sH, 16 * j + r16, SB, 32 * ks + 8 * q4), y2);
                    yo[jj] = y2;
                }
                __syncthreads();
#pragma unroll
                for (int jj = 0; jj < 2; ++jj) { const int j = tj0 + jj;
                    f32x4 acc = (f32x4){0.f, 0.f, 0.f, 0.f};
#pragma unroll
                    for (int ks = 0; ks < 2; ++ks) acc = MFMA16(ldfrag(sW, 16 * ti + r16, SB, 32 * ks + 8 * q4), ldfrag(sXT, 16 * j + r16, SB, 32 * ks + 8 * q4), acc);
#pragma unroll
                    for (int e = 0; e < 4; ++e) { const int l = 16 * ti + 4 * q4 + e; const float y = acc[e] + __expf(scs[l]) * yo[jj][e];
                        const int row = dir ? row_c0 + 63 - l : row_c0 + l; ydir[(size_t)row * D + h * 64 + 16 * j + r16] = (bf16)f2bf(y); }
                }
            }
            const float dcay = __expf(cs_last);
#pragma unroll
            for (int jj = 0; jj < 2; ++jj) { hacc[jj] = hacc[jj] * dcay;
#pragma unroll
                for (int ks = 0; ks < 2; ++ks) hacc[jj] = MFMA16(ldfrag(sBT, 16 * ti + r16, SB, 32 * ks + 8 * q4), ldfrag(sXwT, 16 * (tj0 + jj) + r16, SB, 32 * ks + 8 * q4), hacc[jj]);
                if (FINAL) { const int p = 16 * (tj0 + jj) + r16, n0 = 16 * ti + 4 * q4;
                    u32x2 hv; hv.x = pk2(hacc[jj][0], hacc[jj][1]); hv.y = pk2(hacc[jj][2], hacc[jj][3]); *(LAS u32x2*)(sH + p * SB + n0 * 2) = hv; }
            }
            cs_tot += cs_last;
            __syncthreads();
        }
        if (!FINAL) {
#pragma unroll
            for (int jj = 0; jj < 2; ++jj) { const int p = 16 * (tj0 + jj) + r16, n0 = 16 * ti + 4 * q4; float* sp = ST + (size_t)u * 4096 + n0 * 64 + p;
                sp[0] = hacc[jj][0]; sp[64] = hacc[jj][1]; sp[128] = hacc[jj][2]; sp[192] = hacc[jj][3]; }
            if (tid == 0) DEC[u] = __expf(cs_tot);
        }
    }
}
__device__ __forceinline__ void ssd_passB(float* ST, const float* __restrict__ DEC, int nseq, int nseg) {
    const int gt = blockIdx.x * 512 + tid_opaque(), NT = gridDim.x * 512;
    const int total = nseq * 32 * 4096;
    for (int e = gt; e < total; e += NT) {
        const int el = e & 4095, chain = e >> 12, hd = chain & 31, seq = chain >> 5, h = hd >> 1, dir = hd & 1;
        float run = 0.f;
        for (int i = 0; i < nseg; ++i) { const int sl = dir ? nseg - 1 - i : i, u = ((seq * nseg + sl) * 16 + h) * 2 + dir;
            float* sp = ST + (size_t)u * 4096 + el; const float t = *sp; *sp = run; run = DEC[u] * run + t; }
    }
}
__device__ __forceinline__ void ssd_post(const bf16* __restrict__ proj, const bf16* __restrict__ xact, const bf16* __restrict__ yF, const bf16* __restrict__ yB, bf16* mix, const float* __restrict__ dsk, const float* __restrict__ nw) {
    const int tid = tid_opaque(), lane = tid & 63, wave = tid >> 6;
    const int gw = blockIdx.x * 8 + wave, NGW = gridDim.x * 8;
    for (int it = gw; it < MS * 2; it += NGW) {
        const int row = it >> 1, grp = it & 1, c = grp * 512 + lane * 8;
        float a[8], b[8], x[8], z[8], y[8];
        unpack8(*(const u32x4*)(yF + (size_t)row * D + c), a); unpack8(*(const u32x4*)(yB + (size_t)row * D + c), b);
        unpack8(*(const u32x4*)(xact + (size_t)row * 1280 + c), x); unpack8(*(const u32x4*)(proj + (size_t)row * EV_N + 768 + c), z);
        const float dd = dsk[c >> 6]; float ss = 0.f;
#pragma unroll
        for (int e = 0; e < 8; ++e) { y[e] = (a[e] + b[e] + dd * x[e]) * silu_f(z[e]); ss += y[e] * y[e]; }
        const float rs = rsqrtf(wave_sum(ss) * (1.f / 512.f) + EPS);
        const f32x4 w0 = *(const f32x4*)(nw + c), w1 = *(const f32x4*)(nw + c + 4);
        u32x4 o; o.x = pk2(y[0] * rs * w0.x, y[1] * rs * w0.y); o.y = pk2(y[2] * rs * w0.z, y[3] * rs * w0.w); o.z = pk2(y[4] * rs * w1.x, y[5] * rs * w1.y); o.w = pk2(y[6] * rs * w1.z, y[7] * rs * w1.w);
        *(u32x4*)(mix + (size_t)row * MIXK + 512 + c) = o;
    }
}

template <bool FINAL>
__device__ __forceinline__ void hg_scan(lptr lds, const bf16* __restrict__ proj, const float* __restrict__ lbraw, int j, float* ST, float* DEC, bf16* oF, bf16* oB) {
    const int tid = tid_opaque(), lane = tid & 63, w = tid >> 6, r16 = lane & 15, q4 = lane >> 4;
    constexpr int SQB = 272, STB = 80;
    lptr sQ = lds, sKn = lds + 8704, sKsT = lds + 17408, sVT = lds + 27648, sAtt = lds + 37888, sSt = lds + 40448;
    LAS float* sdc = (LAS float*)(lds + 75264); LAS float* spart = (LAS float*)(lds + 75776);
    const int k = tid & 127, part = tid >> 7;
    for (int u = blockIdx.x; u < 512; u += gridDim.x) {
        const int dir = u & 1, h = (u >> 1) & 7, seg = u >> 4;
        const float lb = (j == 0) ? 0.f : 1.f / (1.f + __expf(lbraw[h * 128 + k] - lbraw[1024 + h * 128 + k]));
        const int row_seg0 = seg * 512;
        bf16* odir = dir ? oB : oF;
        f32x4 sacc[8];
#pragma unroll
        for (int vt = 0; vt < 8; ++vt) {
            if (FINAL) { const int v = 16 * vt + r16, k0 = 16 * w + 4 * q4; const float* sp = ST + (size_t)u * 16384 + k0 * 128 + v;
                sacc[vt] = (f32x4){sp[0], sp[128], sp[256], sp[384]};
                u32x2 hv; hv.x = pk2(sacc[vt][0], sacc[vt][1]); hv.y = pk2(sacc[vt][2], sacc[vt][3]); *(LAS u32x2*)(sSt + v * SQB + k0 * 2) = hv;
            } else sacc[vt] = (f32x4){0.f, 0.f, 0.f, 0.f};
        }
        float gtot = 0.f;
        for (int ci = 0; ci < 16; ++ci) {
            const int c = dir ? 15 - ci : ci, row_c0 = row_seg0 + c * 32;
            float qv[8], kk[8], G[8]; float run = 0.f; unsigned vp[4];
#pragma unroll
            for (int i = 0; i < 8; ++i) { const int l = 8 * part + i, row = dir ? row_c0 + 31 - l : row_c0 + l;
                const bf16* pr = proj + (size_t)row * OD_N + h * 128 + k;
                const float fr = bf2f(pr[1024 + dir * 1024]);
                if (FINAL) qv[i] = silu_f(bf2f(pr[0]));
                const unsigned vb = pr[3072];
                if (i & 1) vp[i >> 1] |= vb << 16; else vp[i >> 1] = vb;
                const float sig = 1.f / (1.f + __expf(-fr)); const float f = lb + (1.f - lb) * sig;
                kk[i] = (1.f - lb) * (1.f - sig); run += __logf(fmaxf(f, 1e-30f)); G[i] = run; }
            spart[part * 128 + k] = run;
            *(LAS u32x4*)(sVT + k * STB + part * 16) = (u32x4){vp[0], vp[1], vp[2], vp[3]};
            __syncthreads();
            float prefix = 0.f, total = 0.f;
#pragma unroll
            for (int pp = 0; pp < 4; ++pp) { const float t = spart[pp * 128 + k]; total += t; if (pp < part) prefix += t; }
            float ks8[8];
#pragma unroll
            for (int i = 0; i < 8; ++i) { const float Gi = prefix + G[i]; const int l = 8 * part + i;
                if (FINAL) { *((LAS bf16*)(sQ + l * SQB) + k) = (bf16)f2bf(qv[i] * __expf(Gi)); *((LAS bf16*)(sKn + l * SQB) + k) = (bf16)f2bf(kk[i] * __expf(fminf(-Gi, 80.f))); }
                ks8[i] = kk[i] * __expf(total - Gi); }
            *(LAS u32x4*)(sKsT + k * STB + part * 16) = (u32x4){pk2(ks8[0], ks8[1]), pk2(ks8[2], ks8[3]), pk2(ks8[4], ks8[5]), pk2(ks8[6], ks8[7])};
            if (part == 0) { sdc[k] = __expf(total); gtot += total; }
            __syncthreads();
            f32x4 oacc[2];
            if (FINAL) {
                if (w < 4) { const int i = w >> 1, jt = w & 1; f32x4 acc = (f32x4){0.f, 0.f, 0.f, 0.f};
                    if (jt <= i) {
#pragma unroll
                        for (int ks = 0; ks < 4; ++ks) acc = MFMA16(ldfrag(sQ, 16 * i + r16, SQB, 32 * ks + 8 * q4), ldfrag(sKn, 16 * jt + r16, SQB, 32 * ks + 8 * q4), acc);
                    }
                    const int s = 16 * jt + r16;
#pragma unroll
                    for (int e = 0; e < 4; ++e) { const int l = 16 * i + 4 * q4 + e; *((LAS bf16*)(sAtt + l * STB) + s) = (bf16)f2bf((s <= l) ? acc[e] : 0.f); }
                }
#pragma unroll
                for (int lt = 0; lt < 2; ++lt) { f32x4 acc = (f32x4){0.f, 0.f, 0.f, 0.f};
#pragma unroll
                    for (int ks = 0; ks < 4; ++ks) acc = MFMA16(ldfrag(sQ, 16 * lt + r16, SQB, 32 * ks + 8 * q4), ldfrag(sSt, 16 * w + r16, SQB, 32 * ks + 8 * q4), acc);
                    oacc[lt] = acc; }
                __syncthreads();
#pragma unroll
                for (int lt = 0; lt < 2; ++lt) { oacc[lt] = MFMA16(ldfrag(sAtt, 16 * lt + r16, STB, 8 * q4), ldfrag(sVT, 16 * w + r16, STB, 8 * q4), oacc[lt]);
#pragma unroll
                    for (int e = 0; e < 4; ++e) { const int l = 16 * lt + 4 * q4 + e, row = dir ? row_c0 + 31 - l : row_c0 + l;
                        odir[(size_t)row * D + h * 128 + 16 * w + r16] = (bf16)f2bf(oacc[lt][e]); } }
            }
            { const bf16x8 af = ldfrag(sKsT, 16 * w + r16, STB, 8 * q4);
              const f32x4 dcv = *(const LAS f32x4*)(sdc + 16 * w + 4 * q4);
#pragma unroll
              for (int vt = 0; vt < 8; ++vt) { sacc[vt] = sacc[vt] * dcv; sacc[vt] = MFMA16(af, ldfrag(sVT, 16 * vt + r16, STB, 8 * q4), sacc[vt]);
                  if (FINAL) { const int v = 16 * vt + r16, k0 = 16 * w + 4 * q4;
                      u32x2 hv; hv.x = pk2(sacc[vt][0], sacc[vt][1]); hv.y = pk2(sacc[vt][2], sacc[vt][3]); *(LAS u32x2*)(sSt + v * SQB + k0 * 2) = hv; } } }
            __syncthreads();
        }
        if (!FINAL) {
#pragma unroll
            for (int vt = 0; vt < 8; ++vt) { const int v = 16 * vt + r16, k0 = 16 * w + 4 * q4; float* sp = ST + (size_t)u * 16384 + k0 * 128 + v;
                sp[0] = sacc[vt][0]; sp[128] = sacc[vt][1]; sp[256] = sacc[vt][2]; sp[384] = sacc[vt][3]; }
            if (part == 0) DEC[u * 128 + k] = __expf(gtot);
        }
    }
}
__device__ __forceinline__ void hg_passB(float* ST, const float* __restrict__ DEC, int nseq, int nseg) {
    const int gt = blockIdx.x * 512 + tid_opaque(), NT = gridDim.x * 512;
    const int total = nseq * 16 * 16384;
    for (int e = gt; e < total; e += NT) {
        const int el = e & 16383, chain = e >> 14, hd = chain & 15, seq = chain >> 4, h = hd >> 1, dir = hd & 1;
        float run = 0.f;
        for (int i = 0; i < nseg; ++i) { const int sl = dir ? nseg - 1 - i : i, u = ((seq * nseg + sl) * 8 + h) * 2 + dir;
            float* sp = ST + (size_t)u * 16384 + el; const float t = *sp; *sp = run; run = DEC[u * 128 + (el >> 7)] * run + t; }
    }
}
__device__ __forceinline__ void hg_post(const bf16* __restrict__ proj, const bf16* __restrict__ oF, const bf16* __restrict__ oB, bf16* mix, const float* __restrict__ nw) {
    const int tid = tid_opaque(), lane = tid & 63, wave = tid >> 6;
    const int gw = blockIdx.x * 8 + wave, NGW = gridDim.x * 8;
    for (int row = gw; row < MS; row += NGW) {
        const int c = lane * 16;
        float a[16], b[8], gg[16];
        unpack8(*(const u32x4*)(oF + (size_t)row * D + c), b);
#pragma unroll
        for (int e = 0; e < 8; ++e) a[e] = b[e];
        unpack8(*(const u32x4*)(oF + (size_t)row * D + c + 8), b);
#pragma unroll
        for (int e = 0; e < 8; ++e) a[8 + e] = b[e];
        unpack8(*(const u32x4*)(oB + (size_t)row * D + c), b);
#pragma unroll
        for (int e = 0; e < 8; ++e) a[e] += b[e];
        unpack8(*(const u32x4*)(oB + (size_t)row * D + c + 8), b);
#pragma unroll
        for (int e = 0; e < 8; ++e) a[8 + e] += b[e];
        unpack8(*(const u32x4*)(proj + (size_t)row * OD_N + 4096 + c), b);
#pragma unroll
        for (int e = 0; e < 8; ++e) gg[e] = b[e];
        unpack8(*(const u32x4*)(proj + (size_t)row * OD_N + 4096 + c + 8), b);
#pragma unroll
        for (int e = 0; e < 8; ++e) gg[8 + e] = b[e];
        float ss = 0.f;
#pragma unroll
        for (int e = 0; e < 16; ++e) ss += a[e] * a[e];
        ss += __shfl_xor(ss, 1); ss += __shfl_xor(ss, 2); ss += __shfl_xor(ss, 4);
        const float rs = rsqrtf(ss * (1.f / 128.f) + EPS);
        float o[16];
#pragma unroll
        for (int e = 0; e < 16; ++e) o[e] = a[e] * rs * nw[(c & 127) + e] * silu_f(gg[e]);
        u32x4 o0, o1; o0.x = pk2(o[0], o[1]); o0.y = pk2(o[2], o[3]); o0.z = pk2(o[4], o[5]); o0.w = pk2(o[6], o[7]);
        o1.x = pk2(o[8], o[9]); o1.y = pk2(o[10], o[11]); o1.z = pk2(o[12], o[13]); o1.w = pk2(o[14], o[15]);
        *(u32x4*)(mix + (size_t)row * D + c) = o0; *(u32x4*)(mix + (size_t)row * D + c + 8) = o1;
    }
}


#define XB_TMO      128
#define XB_XCNT(j)  (256  + 64 * (j))
#define XB_XSUB(j)  (1280 + 64 * (j))
#define XB_XGEN(j)  (2304 + 64 * (j))
#define XB_TOP      3328
#define XB_TOPGEN   3392
#define XCD_BAR_WORDS 3456
#define XB_SPIN_CAP (1u << 18)
__device__ __forceinline__ unsigned xb_ld(unsigned* p)              { return __hip_atomic_load(p, __ATOMIC_RELAXED, __HIP_MEMORY_SCOPE_AGENT); }
__device__ __forceinline__ unsigned xb_add(unsigned* p, unsigned v) { return __hip_atomic_fetch_add(p, v, __ATOMIC_RELAXED, __HIP_MEMORY_SCOPE_AGENT); }
__device__ __forceinline__ unsigned xb_xcc_id() { return (unsigned)__builtin_amdgcn_s_getreg((3 << 11) | 20) & 0xFu; }
#define XB_SPIN(cond, bar) do { unsigned _sp = 0; while (cond) { __builtin_amdgcn_s_sleep(1); \
    if ((++_sp & 255u) == 0u) { if (xb_ld(&(bar)[XB_TMO])) break; if (_sp > XB_SPIN_CAP) { atomicAdd(&(bar)[XB_TMO], 1u); break; } } } } while (0)

struct XcdBarrier {
    unsigned* bar; unsigned x;
    volatile LAS unsigned* st;
};

__device__ __forceinline__ XcdBarrier xcd_barrier_post(unsigned* bar, volatile LAS unsigned* st) {
    XcdBarrier b; b.bar = bar; b.x = xb_xcc_id(); b.st = st;
    if (threadIdx.x == 0) (void)xb_add(&bar[XB_XCNT(b.x)], 1u);
    return b;
}
__device__ __forceinline__ void xcd_barrier_complete(unsigned* bar, unsigned x, unsigned& nloc, unsigned& nx) {
    const unsigned G = gridDim.x * gridDim.y * gridDim.z;
    unsigned sum, cnt, mine, sp = 0u;
    for (;;) {
        sum = 0u; cnt = 0u; mine = 0u;
#pragma unroll
        for (unsigned j = 0; j < 16; ++j) { const unsigned c = xb_ld(&bar[XB_XCNT(j)]); sum += c; cnt += (c > 0u) ? 1u : 0u; mine = (j == x) ? c : mine; }
        if (sum == G) break;
        __builtin_amdgcn_s_sleep(1);
        if ((++sp & 255u) == 0u) { if (xb_ld(&bar[XB_TMO])) break; if (sp > XB_SPIN_CAP) { atomicAdd(&bar[XB_TMO], 1u); break; } }
    }
    nloc = mine > 0u ? mine : 1u; nx = cnt > 0u ? cnt : 1u;
}

__device__ __forceinline__ void xcd_barrier(const XcdBarrier& b) {
    asm volatile("s_waitcnt vmcnt(0)" ::: "memory");
    __syncthreads();
    if (threadIdx.x == 0) {
        unsigned* bar = b.bar;
        __builtin_amdgcn_s_waitcnt(0);
        unsigned nloc = b.st[0], nx = b.st[1];
        if (nloc == 0u) { xcd_barrier_complete(bar, b.x, nloc, nx); b.st[0] = nloc; b.st[1] = nx; }
        const unsigned old = xb_add(&bar[XB_XSUB(b.x)], 1u);
        const unsigned gen = old / nloc;
        if (old + 1u == (gen + 1u) * nloc) {
            __builtin_amdgcn_fence(__ATOMIC_RELEASE, "agent");
            asm volatile("s_waitcnt vmcnt(0)" ::: "memory");
            const unsigned og = xb_add(&bar[XB_TOP], 1u);
            const unsigned tg = og / nx;
            if (og + 1u == (tg + 1u) * nx) xb_add(&bar[XB_TOPGEN], 1u);
            else XB_SPIN(xb_ld(&bar[XB_TOPGEN]) == tg, bar);
            __builtin_amdgcn_fence(__ATOMIC_ACQUIRE, "agent");
            xb_add(&bar[XB_XGEN(b.x)], 1u);
            asm volatile("s_waitcnt vmcnt(0)" ::: "memory");
        } else {
            XB_SPIN(xb_ld(&bar[XB_XGEN(b.x)]) == gen, bar);
            __builtin_amdgcn_fence(__ATOMIC_ACQUIRE, "agent");
            asm volatile("s_waitcnt vmcnt(0)" ::: "memory");
        }
    }
    __syncthreads();
}

constexpr int PH_PER_SLAB = 1 + 2 * (11 + 10);
constexpr int N_PHASES = 1 + NSLAB * PH_PER_SLAB;

__global__ void __launch_bounds__(512, 2) mega(Params P) {
    extern __shared__ __attribute__((aligned(16))) unsigned char lds_raw[];
    lptr lds = (lptr)lds_raw;
    cg::grid_group grid = cg::this_grid();
    volatile LAS unsigned* xst = (volatile LAS unsigned*)(lds + 139264);
    if (threadIdx.x < 2) xst[threadIdx.x] = 0u;
    __syncthreads();
    XcdBarrier xbar = xcd_barrier_post((unsigned*)P.ws, xst);
    const int lo = P.ph_lo, hi = P.ph_hi; int pc = 0;
#define PH(...) do { if (pc >= lo && pc < hi) { __VA_ARGS__; if (pc + 1 < hi) { if (pc == 0) grid.sync(); else xcd_barrier(xbar); } } ++pc; } while (0)
    unsigned char* ws = P.ws;
    bf16* HN = (bf16*)(ws + WS_HN); bf16* PROJ = (bf16*)(ws + WS_PROJ); bf16* XACT = (bf16*)(ws + WS_XACT); bf16* MIX = (bf16*)(ws + WS_MIX);
    float* MB = (float*)(ws + WS_M); bf16* YF = (bf16*)(ws + WS_M); bf16* YB = (bf16*)(ws + WS_M + 32 * MiB);
    float* ST = (float*)(ws + WS_ST); float* DEC = (float*)(ws + WS_DEC); float* DTV = (float*)(ws + WS_DT);
    const float* NG = P.in[2];

    PH(p0_weights(P, lds));
#pragma unroll 1
    for (int slab = 0; slab < NSLAB; ++slab) {
        const float* xin = (slab < 2) ? P.in[0] + (size_t)slab * MS * D : P.in[1];
        float* X = P.out + (size_t)slab * MS * D;
        const int S = (slab < 2) ? 2048 : 16384, nseq = MS / S, nseg = S / 512;
        PH(p_init(xin, X, HN, NG));
#pragma unroll 1
        for (int l = 0; l < DEPTH; ++l) {
            const int j = l >> 1; const float* g = NG + (size_t)l * 4 * D;
            if ((l & 1) == 0) {
                PH({ pg8::Gemm gm{HN, (const bf16*)(ws + WS_EVIN + j * SZ_EVIN), MS, EV_N, D}; pg8::StaticOrder so; so.init(MS, EV_N, gridDim.x, blockIdx.x);
                     pg8::EpiBf16 ep{PROJ, EV_N}; pg8::gemm_phase<pg8::EpiBf16, pg8::StaticOrder, true, true>(lds, gm, so, ep); });
                PH({ p_attn(lds, PROJ, MIX, P.in[3], P.in[5] + j * 8, S);
                     p_conv(PROJ, XACT, DTV, P.in[6] + (size_t)j * 5 * 1280, P.in[7] + j * 1280, P.in[9] + j * 32, S); });
                PH(ssd_scan<false>(lds, XACT, DTV, P.in[8] + j * 32, ST, DEC, YF, YB));
                PH(ssd_passB(ST, DEC, nseq, nseg));
                PH(ssd_scan<true>(lds, XACT, DTV, P.in[8] + j * 32, ST, DEC, YF, YB));
                PH(ssd_post(PROJ, XACT, YF, YB, MIX, P.in[10] + j * 16, P.in[11] + j * 1024));
                PH({ pg8::Gemm gm{MIX, (const bf16*)(ws + WS_EVOUT + j * SZ_EVOUT), MS, D, MIXK}; pg8::StaticOrder so; so.init(MS, D, gridDim.x, blockIdx.x);
                     pg8::EpiF32 ep{MB, D}; pg8::gemm_phase<pg8::EpiF32, pg8::StaticOrder, true, true>(lds, gm, so, ep); });
            } else {
                PH({ pg8::Gemm gm{HN, (const bf16*)(ws + WS_ODIN + j * SZ_ODIN), MS, OD_N, D}; pg8::StaticOrder so; so.init(MS, OD_N, gridDim.x, blockIdx.x);
                     pg8::EpiBf16 ep{PROJ, OD_N}; pg8::gemm_phase<pg8::EpiBf16, pg8::StaticOrder, true, true>(lds, gm, so, ep); });
                PH(hg_scan<false>(lds, PROJ, P.in[14], j, ST, DEC, YF, YB));
                PH(hg_passB(ST, DEC, nseq, nseg));
                PH(hg_scan<true>(lds, PROJ, P.in[14], j, ST, DEC, YF, YB));
                PH(hg_post(PROJ, YF, YB, MIX, P.in[15] + j * 128));
                PH({ pg8::Gemm gm{MIX, (const bf16*)(ws + WS_ODOUT + j * SZ_ODOUT), MS, D, D}; pg8::StaticOrder so; so.init(MS, D, gridDim.x, blockIdx.x);
                     pg8::EpiF32 ep{MB, D}; pg8::gemm_phase<pg8::EpiF32, pg8::StaticOrder, true, true>(lds, gm, so, ep); });
            }
            PH(p_resnorm(X, MB, HN, g + D, g + 2 * D));
            PH({ pg8::Gemm gm{HN, (const bf16*)(ws + WS_FFGU + l * SZ_FFGU), MS, FF2, D}; pg8::StaticOrder so; so.init(MS, FF2, gridDim.x, blockIdx.x);
                 pg8::EpiSwiGLU ep{PROJ, FF}; pg8::gemm_phase<pg8::EpiSwiGLU, pg8::StaticOrder, true, true>(lds, gm, so, ep); });
            PH({ pg8::Gemm gm{PROJ, (const bf16*)(ws + WS_FFD + l * SZ_FFD), MS, D, FF}; pg8::StaticOrder so; so.init(MS, D, gridDim.x, blockIdx.x);
                 pg8::EpiF32 ep{MB, D}; pg8::gemm_phase<pg8::EpiF32, pg8::StaticOrder, true, true>(lds, gm, so, ep); });
            PH(p_resnorm(X, MB, HN, g + 3 * D, (l + 1 < DEPTH) ? g + 4 * D : nullptr));
        }
    }
#undef PH
}

#ifndef N_LAUNCH_MODE
#define N_LAUNCH_MODE 1
#endif
extern "C" void kernel_launch(void* const* d_in, const int* in_sizes, int n_in, void* d_out, int out_size, void* d_ws, size_t ws_size, hipStream_t stream) {
    static int grid = 0;
    if (grid == 0) {
        if (n_in != 20 || ws_size < WS_END) { fprintf(stderr, "kernel_launch: unexpected n_in %d / ws %zu\n", n_in, ws_size); grid = -1; return; }
        int dev = 0, cus = 0, per_cu = 0;
        hipGetDevice(&dev); hipDeviceGetAttribute(&cus, hipDeviceAttributeMultiprocessorCount, dev);
        hipFuncSetAttribute((const void*)mega, hipFuncAttributeMaxDynamicSharedMemorySize, LDS_BYTES);
        hipOccupancyMaxActiveBlocksPerMultiprocessor(&per_cu, (const void*)mega, 512, LDS_BYTES);
        (void)hipGetLastError();
        if (per_cu < 1) per_cu = 1;
        grid = cus * 1;
        if (grid > 256) grid = 256;
    }
    if (grid < 0) return;
    Params p{};
    for (int i = 0; i < 20; ++i) p.in[i] = (const float*)d_in[i];
    p.out = (float*)d_out; p.ws = (unsigned char*)d_ws;
#if N_LAUNCH_MODE == 1
    (void)hipMemsetAsync(d_ws, 0, 16384, stream);
    p.ph_lo = 0; p.ph_hi = N_PHASES;
    void* args[] = {&p};
    hipError_t e = hipLaunchCooperativeKernel((const void*)mega, dim3(grid), dim3(512), args, LDS_BYTES, stream);
    if (e != hipSuccess) fprintf(stderr, "cooperative launch failed: %s (grid %d)\n", hipGetErrorString(e), grid);
#else
    for (int ph = 0; ph < N_PHASES; ++ph) { p.ph_lo = ph; p.ph_hi = ph + 1; hipLaunchKernelGGL(mega, dim3(grid), dim3(512), LDS_BYTES, stream, p); }
#endif
}
```
